# Optimizing an MI355X kernel written in HIP

```python
import jax, jax.numpy as jnp
from jax import lax
import numpy as np

D_MODEL = 1024
BATCH = 8
SEQ = 4096
DEPTH = 4

GRID_W = 64
CTX_LEN = 256
HEAD_DIM = 64
ATTN_HEADS = 8
KV_HEADS = 2
GQA_GROUP = ATTN_HEADS // KV_HEADS
ATTN_WIDTH = ATTN_HEADS * HEAD_DIM
KV_WIDTH = KV_HEADS * HEAD_DIM
MLP_HEADS = 8
MLP_WIDTH = MLP_HEADS * HEAD_DIM
CHUNK = 128
Q_BLOCK = 128
MIX_WIDTH = ATTN_WIDTH + MLP_WIDTH
IN_WIDTH = ATTN_WIDTH + 2 * KV_WIDTH + 2 * MLP_WIDTH
FFN_HIDDEN = -(-8 * D_MODEL // (3 * 256)) * 256
N_MOD = 6
ROPE_THETA = 10000.0
ROPE_AXIS_DIM = HEAD_DIM // 2
EPS = 1e-6

kernel_name = "hybrid_gqa_gmlp_diffusion_trunk"


def rms_norm(x, g):
    xf = x.astype(jnp.float32)
    y = xf * lax.rsqrt(jnp.mean(xf * xf, axis=-1, keepdims=True) + EPS)
    return (y * g.astype(jnp.float32)).astype(x.dtype)


def layer_norm(x, g, b):
    xf = x.astype(jnp.float32)
    mu = jnp.mean(xf, axis=-1, keepdims=True)
    var = jnp.mean(jnp.square(xf - mu), axis=-1, keepdims=True)
    y = (xf - mu) * lax.rsqrt(var + EPS)
    return (y * g.astype(jnp.float32) + b.astype(jnp.float32)).astype(x.dtype)


def modulate(h, shift, scale):
    return h * (1 + scale) + shift


def axial_rope_tables(n):
    rows = n // GRID_W
    pos_row = jnp.broadcast_to(jnp.arange(rows, dtype=jnp.float32)[:, None], (rows, GRID_W)).reshape(-1)
    pos_col = jnp.broadcast_to(jnp.arange(GRID_W, dtype=jnp.float32)[None, :], (rows, GRID_W)).reshape(-1)
    inv = ROPE_THETA ** (-jnp.arange(0, ROPE_AXIS_DIM, 2, dtype=jnp.float32) / ROPE_AXIS_DIM)
    ang = jnp.concatenate([pos_row[:, None] * inv, pos_col[:, None] * inv], axis=-1)
    return jnp.cos(ang), jnp.sin(ang)


def apply_rope(x, cos, sin):
    b, n, h, d = x.shape
    half = ROPE_AXIS_DIM // 2
    xr = x.reshape(b, n, h, 2, 2, half)
    c = cos.reshape(n, 2, half)[None, :, None].astype(x.dtype)
    s = sin.reshape(n, 2, half)[None, :, None].astype(x.dtype)
    x1, x2 = xr[..., 0, :], xr[..., 1, :]
    out = jnp.stack([x1 * c - x2 * s, x1 * s + x2 * c], axis=-2)
    return out.reshape(b, n, h, d)


def split_proj(p):
    b, n = p.shape[:2]
    q, k, v, z = jnp.split(p, [ATTN_WIDTH, ATTN_WIDTH + KV_WIDTH, ATTN_WIDTH + 2 * KV_WIDTH], axis=-1)
    return (q.reshape(b, n, ATTN_HEADS, HEAD_DIM), k.reshape(b, n, KV_HEADS, HEAD_DIM),
            v.reshape(b, n, KV_HEADS, HEAD_DIM), z)


def latent_attention(q, k_all, v_all):
    b, n = q.shape[:2]
    nblk = n // Q_BLOCK
    scale = 1.0 / np.sqrt(HEAD_DIM)
    qb = q.reshape(b, nblk, Q_BLOCK, KV_HEADS, GQA_GROUP, HEAD_DIM).transpose(1, 0, 3, 4, 2, 5)
    kt = k_all.transpose(0, 2, 1, 3)
    vt = v_all.transpose(0, 2, 1, 3)

    def one_block(qblk):
        s = jnp.einsum("bkgqd,bksd->bkgqs", qblk, kt, preferred_element_type=jnp.float32) * scale
        p = jax.nn.softmax(s, axis=-1).astype(vt.dtype)
        return jnp.einsum("bkgqs,bksd->bkgqd", p, vt)

    ob = lax.map(one_block, qb)
    return ob.transpose(1, 0, 4, 2, 3, 5).reshape(b, n, ATTN_WIDTH)


def context_attention(q, k, v):
    b, L = q.shape[:2]
    scale = 1.0 / np.sqrt(HEAD_DIM)
    qg = q.reshape(b, L, KV_HEADS, GQA_GROUP, HEAD_DIM)
    s = jnp.einsum("blkgd,bmkd->bkglm", qg, k, preferred_element_type=jnp.float32) * scale
    p = jax.nn.softmax(s, axis=-1).astype(v.dtype)
    o = jnp.einsum("bkglm,bmkd->blkgd", p, v)
    return o.reshape(b, L, ATTN_WIDTH)


def chunk_spatial_gating(z, g_sg, b_sg, w_s, b_s):
    b, n = z.shape[:2]
    z = jax.nn.gelu(z)
    u, v = jnp.split(z, 2, axis=-1)
    v = layer_norm(v, g_sg, b_sg)
    v = v.reshape(b, n // CHUNK, CHUNK, MLP_HEADS, HEAD_DIM)
    s = jnp.einsum("hpq,bcqhd->bcphd", w_s, v) + b_s.T[None, None, :, :, None]
    return u * s.reshape(b, n, MLP_WIDTH)


def swiglu(h, w_ffn_in, w_ffn_out):
    gate, up = jnp.split(h @ w_ffn_in, 2, axis=-1)
    return (jax.nn.silu(gate) * up) @ w_ffn_out


def setup_inputs(seed: int = 0) -> dict:
    key = jax.random.key(seed)
    ks = jax.random.split(key, 20)
    f32 = jnp.float32
    nrm = lambda k, shape, s: jax.random.normal(k, shape, f32) * s
    return {
        "x": nrm(ks[0], (BATCH, SEQ, D_MODEL), 1.0),
        "c": nrm(ks[1], (BATCH, D_MODEL), 1.0),
        "ctx": nrm(ks[2], (BATCH, CTX_LEN, D_MODEL), 1.0),
        "c_ctx": nrm(ks[3], (D_MODEL,), 1.0),
        "w_mod": nrm(ks[4], (DEPTH, D_MODEL, N_MOD * D_MODEL), 0.3 * D_MODEL ** -0.5),
        "b_mod": nrm(ks[5], (DEPTH, N_MOD * D_MODEL), 0.02),
        "g_pre_mix": 1.0 + nrm(ks[6], (DEPTH, D_MODEL), 0.02),
        "g_post_mix": 1.0 + nrm(ks[7], (DEPTH, D_MODEL), 0.02),
        "g_pre_ffn": 1.0 + nrm(ks[8], (DEPTH, D_MODEL), 0.02),
        "g_post_ffn": 1.0 + nrm(ks[9], (DEPTH, D_MODEL), 0.02),
        "w_in": nrm(ks[10], (DEPTH, D_MODEL, IN_WIDTH), D_MODEL ** -0.5),
        "g_q": 1.0 + nrm(ks[11], (DEPTH, HEAD_DIM), 0.02),
        "g_k": 1.0 + nrm(ks[12], (DEPTH, HEAD_DIM), 0.02),
        "g_sg": 1.0 + nrm(ks[13], (DEPTH, MLP_WIDTH), 0.02),
        "b_sg": nrm(ks[14], (DEPTH, MLP_WIDTH), 0.02),
        "w_s": nrm(ks[15], (DEPTH, MLP_HEADS, CHUNK, CHUNK), CHUNK ** -0.5),
        "b_s": 1.0 + nrm(ks[16], (DEPTH, MLP_HEADS, CHUNK), 0.02),
        "w_out": nrm(ks[17], (DEPTH, MIX_WIDTH, D_MODEL), MIX_WIDTH ** -0.5),
        "w_ffn_in": nrm(ks[18], (DEPTH, D_MODEL, 2 * FFN_HIDDEN), D_MODEL ** -0.5),
        "w_ffn_out": nrm(ks[19], (DEPTH, FFN_HIDDEN, D_MODEL), FFN_HIDDEN ** -0.5),
    }


def reference(x, c, ctx, c_ctx, w_mod, b_mod, g_pre_mix, g_post_mix, g_pre_ffn, g_post_ffn,
              w_in, g_q, g_k, g_sg, b_sg, w_s, b_s, w_out, w_ffn_in, w_ffn_out):
    b, n = x.shape[:2]
    cos, sin = axial_rope_tables(n)
    silu_c = jax.nn.silu(c)
    silu_cc = jax.nn.silu(c_ctx)
    xc = ctx
    for l in range(DEPTH):
        last = l == DEPTH - 1
        m_x = (silu_c @ w_mod[l] + b_mod[l]).reshape(b, N_MOD, D_MODEL)
        mx = [m_x[:, i, None, :] for i in range(N_MOD)]
        m_c = (silu_cc @ w_mod[l] + b_mod[l]).reshape(N_MOD, D_MODEL)
        mc = [m_c[i] for i in range(N_MOD)]

        hx = modulate(rms_norm(x, g_pre_mix[l]), mx[0], mx[1])
        hc = modulate(rms_norm(xc, g_pre_mix[l]), mc[0], mc[1])
        qx, kx, vx, zx = split_proj(hx @ w_in[l])
        qx = apply_rope(rms_norm(qx, g_q[l]), cos, sin)
        kx = apply_rope(rms_norm(kx, g_k[l]), cos, sin)
        if last:
            kv_c = hc @ w_in[l][:, ATTN_WIDTH:ATTN_WIDTH + 2 * KV_WIDTH]
            kc, vc = jnp.split(kv_c, 2, axis=-1)
            kc = kc.reshape(b, -1, KV_HEADS, HEAD_DIM)
            vc = vc.reshape(b, -1, KV_HEADS, HEAD_DIM)
        else:
            qc, kc, vc, zc = split_proj(hc @ w_in[l])
            qc = rms_norm(qc, g_q[l])
        kc = rms_norm(kc, g_k[l])
        k_all = jnp.concatenate([kc, kx], axis=1)
        v_all = jnp.concatenate([vc, vx], axis=1)
        attn_x = latent_attention(qx, k_all, v_all)
        mlp_x = chunk_spatial_gating(zx, g_sg[l], b_sg[l], w_s[l], b_s[l])
        out_x = jnp.concatenate([attn_x, mlp_x], axis=-1) @ w_out[l]
        x = x + mx[2] * rms_norm(out_x, g_post_mix[l])
        if not last:
            attn_c = context_attention(qc, kc, vc)
            mlp_c = chunk_spatial_gating(zc, g_sg[l], b_sg[l], w_s[l], b_s[l])
            out_c = jnp.concatenate([attn_c, mlp_c], axis=-1) @ w_out[l]
            xc = xc + mc[2] * rms_norm(out_c, g_post_mix[l])

        fx = swiglu(modulate(rms_norm(x, g_pre_ffn[l]), mx[3], mx[4]), w_ffn_in[l], w_ffn_out[l])
        x = x + mx[5] * rms_norm(fx, g_post_ffn[l])
        if not last:
            fc = swiglu(modulate(rms_norm(xc, g_pre_ffn[l]), mc[3], mc[4]), w_ffn_in[l], w_ffn_out[l])
            xc = xc + mc[5] * rms_norm(fc, g_post_ffn[l])
    return x
```

```cpp
#include <hip/hip_runtime.h>
#include <cstdio>
#include <cstdint>
__device__ __forceinline__ int tid_fresh() { int t = threadIdx.x; asm volatile("" : "+v"(t)); return t; }
namespace pg8 {
#define PG8_LAS __attribute__((address_space(3)))
typedef unsigned short bf16_t;
typedef short bf16x8 __attribute__((ext_vector_type(8)));
typedef float f32x4 __attribute__((ext_vector_type(4)));
typedef unsigned u32x4 __attribute__((ext_vector_type(4)));
constexpr int BM = 256, BK = 64, HALF = 128, HTB = HALF * BK * 2  , STAGE_BYTES = 8 * HTB, NXCD = 8, WGM = 8;

__host__ __device__ __forceinline__ int lds_byte(int r, int c) { const int st = (r >> 4) * 2 + (c >> 5), rr = r & 15, cc = c & 31, ob = rr * 64 + cc * 2; return st * 1024 + (ob ^ (((ob >> 9) & 1) << 5)); }
__host__ __device__ __forceinline__ void stage_rc(int b, int& R, int& C) { const int st = b / 1024, sb = b % 1024, swz = sb ^ (((sb >> 9) & 1) << 5); R = (st >> 1) * 16 + swz / 64; C = (st & 1) * 32 + (swz % 64) / 2; }
__host__ __device__ __forceinline__ int perm32(int rho) { const int n = rho >> 4, i = rho & 15; return 8 * (i >> 2) + 4 * n + (i & 3); }

struct Unit { int pm, pn; };
struct Gemm { const bf16_t* A; const bf16_t* Bt; int M, N, K; };

struct StaticOrder {
    int nM, nN, nwg, G, c;
    __host__ __device__ void init(int M, int N, int G_, int c_) { nM = M / BM; nN = N / BM; nwg = nM * nN; G = G_; c = c_; }
    __host__ __device__ bool next(int i, Unit& u) const {
        const long L = (long)i * G + c; if (L >= nwg) return false;
        int wgid = (int)L; { const int q = nwg / NXCD, r = nwg % NXCD, xcd = wgid % NXCD, off = wgid / NXCD; wgid = (xcd < r ? xcd * (q + 1) : r * (q + 1) + (xcd - r) * q) + off; }
        const int nig = WGM * nN, gid = wgid / nig, fm = gid * WGM, gsz = (nM - fm) < WGM ? (nM - fm) : WGM;
        u.pm = fm + ((wgid % nig) % gsz); u.pn = (wgid % nig) / gsz; return true;
    }
    __device__ __forceinline__ void a_ready(const Unit&) const {}
    __device__ __forceinline__ void done(const Unit&) const {}
};

__device__ __forceinline__ unsigned cvt_pk_bf16(float lo, float hi) { unsigned r; asm volatile("v_cvt_pk_bf16_f32 %0, %1, %2" : "=v"(r) : "v"(lo), "v"(hi)); return r; }
typedef float f32x2 __attribute__((ext_vector_type(2)));
__device__ __forceinline__ f32x2 gelu_pk(f32x2 v) {
    const f32x2 av = __builtin_elementwise_abs(v), d = av * 0.2316418882f + 1.0f;
    f32x2 t; t.x = __builtin_amdgcn_rcpf(d.x); t.y = __builtin_amdgcn_rcpf(d.y);
    f32x2 q = t * 0.5307027145f + (-0.7265760135f); q = q * t + 0.7107068705f; q = q * t + (-0.142248368f); q = q * t + 0.127414796f; q = q * t;
    const f32x2 s = (v * v) * (-0.72134752044f);
    f32x2 e; e.x = __builtin_amdgcn_exp2f(s.x); e.y = __builtin_amdgcn_exp2f(s.y);
    const f32x2 m = v * (q * e), r = v - m;
    f32x2 o; o.x = v.x < 0.f ? m.x : r.x; o.y = v.y < 0.f ? m.y : r.y; return o;
}

template <int ACT  > struct EpiBf16 {
    static constexpr bool PERM = true, AFTER_DRAIN = false; static_assert(ACT == 0 || ACT == 1, "EpiBf16: ACT is 0 (none) or 1 (gelu_pk)");
    bf16_t* O; int ldc; const float* bias; int split_cols; size_t split_stride; float scale0;
    __device__ __forceinline__ void operator()(const f32x4 (&acc)[2][2][4][2], const Unit& u, int wr, int wc, int fr, int fq) const {
        const int row0 = u.pm * BM + wr * 64 + fr; int colt = u.pn * BM; bf16_t* base = O;
        float sc = 1.f; if (split_cols) { const int t = colt / split_cols; base += (size_t)t * split_stride; colt -= t * split_cols; if (t == 0) sc = scale0; }
        const int col0 = colt + wc * 32 + 8 * fq, bcol0 = u.pn * BM + wc * 32 + 8 * fq;
        f32x4 bv[2][2];
#pragma unroll
        for (int bj = 0; bj < 2; ++bj)
#pragma unroll
            for (int n = 0; n < 2; ++n) bv[bj][n] = bias ? *(const f32x4*)(bias + bcol0 + bj * HALF + 4 * n) : (f32x4){0.f, 0.f, 0.f, 0.f};
#pragma unroll
        for (int ai = 0; ai < 2; ++ai)
#pragma unroll
            for (int m = 0; m < 4; ++m) { bf16_t* rowp = base + (size_t)(row0 + ai * HALF + m * 16) * ldc + col0;
#pragma unroll
                for (int bj = 0; bj < 2; ++bj) { f32x4 v0 = acc[ai][bj][m][0] + bv[bj][0], v1 = acc[ai][bj][m][1] + bv[bj][1];
                    if (ACT == 1) { f32x2 a = gelu_pk((f32x2){v0[0], v0[1]}), b = gelu_pk((f32x2){v0[2], v0[3]}), c = gelu_pk((f32x2){v1[0], v1[1]}), d = gelu_pk((f32x2){v1[2], v1[3]});
                        v0 = (f32x4){a.x, a.y, b.x, b.y}; v1 = (f32x4){c.x, c.y, d.x, d.y}; }
                    v0 = v0 * sc; v1 = v1 * sc; u32x4 w; w.x = cvt_pk_bf16(v0[0], v0[1]); w.y = cvt_pk_bf16(v0[2], v0[3]); w.z = cvt_pk_bf16(v1[0], v1[1]); w.w = cvt_pk_bf16(v1[2], v1[3]);
                    *(u32x4*)(rowp + bj * HALF) = w; } }
    }
};
template <class Epi, class Sched, bool ALIGN_EPI = false, bool SP2 = false>
__device__ __forceinline__ void gemm_phase(PG8_LAS unsigned char* lds, const Gemm g, const Sched& S, const Epi& E) {
    const int tid = tid_fresh(), wid = __builtin_amdgcn_readfirstlane(tid >> 6), lane = tid & 63, wr = wid >> 2, wc = wid & 3, fr = lane & 15, fq = lane >> 4;
    const int K = g.K, nt = K / BK;
    unsigned voffA[2], voffB[2];
#pragma unroll
    for (int i = 0; i < 2; ++i) { int R, C; stage_rc(tid * 16 + i * 8192, R, C); const int Rb = Epi::PERM ? ((R & ~31) + perm32(R & 31)) : R;
        voffA[i] = (unsigned)(R * K + C) * 2u; voffB[i] = (unsigned)(Rb * K + C) * 2u; }
    const size_t kstep = (size_t)(BK * 2);
    const size_t hstep = (size_t)HALF * K * 2;
    const size_t tstep = 2 * hstep;
    const unsigned ldsw = (unsigned)wid * 1024u;
    const int aoff = lds_byte(wr * 64 + fr, fq * 8), boff = lds_byte(wc * 32 + fr, fq * 8);
#define PG8_SA(b, h) (((b) * 2 + (h)) * HTB)
#define PG8_SB(b, h) ((4 + (b) * 2 + (h)) * HTB)
#define PG8_STAGE(bufoff, gbase, voff) do { _Pragma("unroll") for (int _i = 0; _i < 2; ++_i) \
        __builtin_amdgcn_global_load_lds((const unsigned*)((const char*)(gbase) + (voff)[_i]), (PG8_LAS unsigned*)(lds + (bufoff) + ldsw + _i * 8192), 16, 0, 0); } while (0)
#define PG8_LDA(dst, b, h) do { _Pragma("unroll") for (int m = 0; m < 4; ++m) _Pragma("unroll") for (int k = 0; k < 2; ++k) dst[m][k] = *(const PG8_LAS bf16x8*)(lds + PG8_SA(b, h) + aoff + m * 2048 + k * 1024); } while (0)
#define PG8_LDB(dst, b, h) do { _Pragma("unroll") for (int n = 0; n < 2; ++n) _Pragma("unroll") for (int k = 0; k < 2; ++k) dst[n][k] = *(const PG8_LAS bf16x8*)(lds + PG8_SB(b, h) + boff + n * 2048 + k * 1024); } while (0)
#define PG8_MMA(ai, bj, At, Bt) do { __builtin_amdgcn_s_setprio(1); _Pragma("unroll") for (int m = 0; m < 4; ++m) _Pragma("unroll") for (int n = 0; n < 2; ++n) _Pragma("unroll") for (int k = 0; k < 2; ++k) \
        acc[ai][bj][m][n] = __builtin_amdgcn_mfma_f32_16x16x32_bf16(Bt[n][k], At[m][k], acc[ai][bj][m][n], 0, 0, 0); __builtin_amdgcn_s_setprio(0); } while (0)
#define PG8_WAIT_V(n) asm volatile("s_waitcnt vmcnt(" #n ")" ::: "memory")
#define PG8_WAIT_L(n) asm volatile("s_waitcnt lgkmcnt(" #n ")" ::: "memory")
#define PG8_BAR __builtin_amdgcn_s_barrier()
#define PG8_SCHED __builtin_amdgcn_sched_barrier(0)
    Unit cur, nxt; int ui = 0;
    if (!S.next(0, cur)) return;
    f32x4 acc[2][2][4][2];
#pragma unroll
    for (int a = 0; a < 2; ++a)
#pragma unroll
        for (int b = 0; b < 2; ++b)
#pragma unroll
            for (int m = 0; m < 4; ++m)
#pragma unroll
                for (int n = 0; n < 2; ++n) acc[a][b][m][n] = (f32x4){0.f, 0.f, 0.f, 0.f};
    bf16x8 At[4][2], B0[2][2], B1[2][2];
    const char* cA = (const char*)g.A + (size_t)cur.pm * tstep; const char* cB = (const char*)g.Bt + (size_t)cur.pn * tstep;
    S.a_ready(cur);
    if constexpr (SP2) {
        PG8_STAGE(PG8_SB(0, 0), cB, voffB); PG8_STAGE(PG8_SB(0, 1), cB + hstep, voffB); PG8_STAGE(PG8_SA(0, 0), cA, voffA); PG8_STAGE(PG8_SA(0, 1), cA + hstep, voffA);
        if (wr == 1) PG8_BAR;
        PG8_WAIT_V(2); PG8_BAR;
        PG8_STAGE(PG8_SB(1, 0), cB + kstep, voffB); PG8_STAGE(PG8_SA(1, 0), cA + kstep, voffA); PG8_STAGE(PG8_SB(1, 1), cB + hstep + kstep, voffB);
        PG8_WAIT_V(6); PG8_BAR;
    } else {
        PG8_STAGE(PG8_SB(0, 0), cB, voffB); PG8_STAGE(PG8_SA(0, 0), cA, voffA); PG8_STAGE(PG8_SB(0, 1), cB + hstep, voffB); PG8_STAGE(PG8_SA(0, 1), cA + hstep, voffA);
        if (wr == 1) PG8_BAR;
        PG8_WAIT_V(4); PG8_BAR;
        PG8_STAGE(PG8_SB(1, 0), cB + kstep, voffB); PG8_STAGE(PG8_SA(1, 0), cA + kstep, voffA); PG8_STAGE(PG8_SB(1, 1), cB + hstep + kstep, voffB);
        PG8_WAIT_V(6); PG8_BAR;
    }
    for (;;) {
        const bool has_next = S.next(ui + 1, nxt);
        const char* nA = has_next ? (const char*)g.A + (size_t)nxt.pm * tstep : cA; const char* nB = has_next ? (const char*)g.Bt + (size_t)nxt.pn * tstep : cB;
        for (int t = 0; t < nt; t += 2) {
            const bool last = (t == nt - 2);
            const char* a1 = cA + (size_t)(t + 1) * kstep;
            const char* a2 = last ? nA : cA + (size_t)(t + 2) * kstep; const char* b2 = last ? nB : cB + (size_t)(t + 2) * kstep;
            const char* a3 = a2 + kstep; const char* b3 = b2 + kstep;
            if (last && has_next) S.a_ready(nxt);
            if constexpr (SP2) {
            PG8_LDB(B0, 0, 0); PG8_LDB(B1, 0, 1); PG8_SCHED; PG8_LDA(At, 0, 0); PG8_STAGE(PG8_SA(1, 1), a1 + hstep, voffA);
            PG8_WAIT_V(8); PG8_WAIT_L(0); PG8_BAR; PG8_MMA(0, 0, At, B0); PG8_MMA(0, 1, At, B1); PG8_BAR; PG8_SCHED;
            PG8_LDA(At, 0, 1); PG8_STAGE(PG8_SB(0, 0), b2, voffB); PG8_STAGE(PG8_SB(0, 1), b2 + hstep, voffB); PG8_STAGE(PG8_SA(0, 0), a2, voffA);
            PG8_WAIT_V(8); PG8_WAIT_L(0); PG8_BAR; PG8_MMA(1, 0, At, B0); PG8_MMA(1, 1, At, B1); PG8_BAR; PG8_SCHED;
            PG8_LDB(B0, 1, 0); PG8_LDB(B1, 1, 1); PG8_SCHED; PG8_LDA(At, 1, 0); PG8_STAGE(PG8_SA(0, 1), a2 + hstep, voffA);
            PG8_WAIT_V(8); PG8_WAIT_L(0); PG8_BAR; PG8_MMA(0, 0, At, B0); PG8_MMA(0, 1, At, B1); PG8_BAR; PG8_SCHED;
            PG8_LDA(At, 1, 1); PG8_STAGE(PG8_SB(1, 0), b3, voffB); PG8_STAGE(PG8_SB(1, 1), b3 + hstep, voffB); PG8_STAGE(PG8_SA(1, 0), a3, voffA);
            PG8_WAIT_V(8); PG8_WAIT_L(0); PG8_BAR; PG8_MMA(1, 0, At, B0); PG8_MMA(1, 1, At, B1); PG8_BAR; PG8_SCHED;
            } else {
            PG8_LDB(B0, 0, 0); PG8_SCHED; PG8_LDA(At, 0, 0); PG8_STAGE(PG8_SA(1, 1), a1 + hstep, voffA);
            PG8_WAIT_L(8); PG8_BAR; PG8_WAIT_L(0); PG8_MMA(0, 0, At, B0); PG8_BAR; PG8_SCHED;
            PG8_LDB(B1, 0, 1); PG8_STAGE(PG8_SB(0, 0), b2, voffB);
            PG8_BAR; PG8_WAIT_L(0); PG8_MMA(0, 1, At, B1); PG8_BAR;
            PG8_LDA(At, 0, 1); PG8_STAGE(PG8_SA(0, 0), a2, voffA);
            PG8_BAR; PG8_WAIT_L(0); PG8_MMA(1, 0, At, B0); PG8_BAR; PG8_SCHED;
            PG8_STAGE(PG8_SB(0, 1), b2 + hstep, voffB);
            PG8_WAIT_V(6); PG8_BAR; PG8_MMA(1, 1, At, B1); PG8_BAR;
            PG8_LDB(B0, 1, 0); PG8_SCHED; PG8_LDA(At, 1, 0); PG8_STAGE(PG8_SA(0, 1), a2 + hstep, voffA);
            PG8_WAIT_L(8); PG8_BAR; PG8_WAIT_L(0); PG8_MMA(0, 0, At, B0); PG8_BAR; PG8_SCHED;
            PG8_LDB(B1, 1, 1); PG8_STAGE(PG8_SB(1, 0), b3, voffB);
            PG8_BAR; PG8_WAIT_L(0); PG8_MMA(0, 1, At, B1); PG8_BAR;
            PG8_LDA(At, 1, 1); PG8_STAGE(PG8_SA(1, 0), a3, voffA);
            PG8_BAR; PG8_WAIT_L(0); PG8_MMA(1, 0, At, B0); PG8_BAR; PG8_SCHED;
            PG8_STAGE(PG8_SB(1, 1), b3 + hstep, voffB);
            PG8_WAIT_V(6); PG8_BAR; PG8_MMA(1, 1, At, B1); PG8_BAR;
            }
        }
        if constexpr (ALIGN_EPI) { if (wr == 0) PG8_BAR; }
        if constexpr (!Epi::AFTER_DRAIN) { E(acc, cur, wr, wc, fr, fq); S.done(cur); }
        if (!has_next) break;
#pragma unroll
        for (int a = 0; a < 2; ++a)
#pragma unroll
            for (int b = 0; b < 2; ++b)
#pragma unroll
                for (int m = 0; m < 4; ++m)
#pragma unroll
                    for (int n = 0; n < 2; ++n) acc[a][b][m][n] = (f32x4){0.f, 0.f, 0.f, 0.f};
        cur = nxt; cA = nA; cB = nB; ++ui;
        if constexpr (ALIGN_EPI) { if (wr == 1) PG8_BAR; }
    }
    PG8_WAIT_V(0);
    if constexpr (!ALIGN_EPI) { if (wr == 0) PG8_BAR; }
    PG8_BAR;
    if constexpr (Epi::AFTER_DRAIN) { E.fused(acc, cur, wr, wc, fr, fq, lds, wid, lane); S.done(cur); }
#undef PG8_SA
#undef PG8_SB
#undef PG8_STAGE
#undef PG8_LDA
#undef PG8_LDB
#undef PG8_MMA
#undef PG8_WAIT_V
#undef PG8_WAIT_L
#undef PG8_BAR
#undef PG8_SCHED
}
}

#include <hip/hip_cooperative_groups.h>
namespace cg = cooperative_groups;

#define LAS __attribute__((address_space(3)))
typedef unsigned short bf16;
typedef float f32x4 __attribute__((ext_vector_type(4)));
typedef float f32x16 __attribute__((ext_vector_type(16)));
typedef short bf16x8 __attribute__((ext_vector_type(8)));
typedef short s16x4 __attribute__((ext_vector_type(4)));
typedef unsigned u32x4 __attribute__((ext_vector_type(4)));
typedef unsigned u32x2 __attribute__((ext_vector_type(2)));

constexpr int DM = 1024, NB = 8, SEQ = 4096, CTXL = 256, DEPTH = 4;
constexpr int RPB = SEQ + CTXL;
constexpr int M = NB * RPB;
constexpr int INW = 1792, FFH = 2816, FF2 = 2 * FFH;
constexpr int NMOD = 6;
constexpr float EPS = 1e-6f;
constexpr int NWAVES = 8, NTHR = 512;
constexpr int LDS_STAGE = 131072, LDS_BYTES = LDS_STAGE + 256;

constexpr size_t al256(size_t x) { return (x + 255) / 256 * 256; }
constexpr size_t WS_WIN = 0;
constexpr size_t WS_WOUT = WS_WIN + al256((size_t)DEPTH * INW * DM * 2);
constexpr size_t WS_WF1 = WS_WOUT + al256((size_t)DEPTH * DM * DM * 2);
constexpr size_t WS_WF2 = WS_WF1 + al256((size_t)DEPTH * FF2 * DM * 2);
constexpr size_t WS_WS = WS_WF2 + al256((size_t)DEPTH * DM * FFH * 2);
constexpr size_t WS_MOD = WS_WS + al256((size_t)DEPTH * 8 * 128 * 128 * 2);
constexpr size_t WS_ROPE = WS_MOD + al256((size_t)DEPTH * 9 * NMOD * DM * 4);
constexpr size_t WS_STATS = WS_ROPE + al256(2 * 64 * 16 * 4);
constexpr size_t WS_XC = WS_STATS + al256((size_t)M * 16 * 4);
constexpr size_t WS_H = WS_XC + al256((size_t)NB * CTXL * DM * 4);
constexpr size_t WS_Y = WS_H + al256((size_t)M * DM * 2);
constexpr size_t WS_BIG = WS_Y + al256((size_t)M * DM * 2);
constexpr size_t WS_Q = WS_BIG;
constexpr size_t WS_K = WS_Q + (size_t)M * 512 * 2;
constexpr size_t WS_V = WS_K + (size_t)M * 128 * 2;
constexpr size_t WS_U = WS_V + (size_t)M * 128 * 2;
constexpr size_t WS_VG = WS_U + (size_t)M * 512 * 2;
constexpr size_t WS_MIX = WS_VG + (size_t)M * 512 * 2;
constexpr size_t WS_END = WS_BIG + al256((size_t)M * FFH * 2);
constexpr size_t WS_BAR = WS_END, BAR_BYTES = 16384, WS_TOTAL = WS_BAR + BAR_BYTES;
static_assert(WS_MIX + (size_t)M * DM * 2 <= WS_END, "overlay");

struct Args {
    const float *x, *c, *ctx, *c_ctx, *w_mod, *b_mod, *g_pre_mix, *g_post_mix, *g_pre_ffn, *g_post_ffn, *w_in, *g_q, *g_k, *g_sg, *b_sg, *w_s, *b_s, *w_out, *w_ffn_in, *w_ffn_out;
    float* out; unsigned char* ws; int ph_lo, ph_hi;
};

typedef const __attribute__((address_space(4))) Args* ArgP;

#define XB_TMO      128
#define XB_XCNT(j)  (256  + 64 * (j))
#define XB_XSUB(j)  (1280 + 64 * (j))
#define XB_XGEN(j)  (2304 + 64 * (j))
#define XB_TOP      3328
#define XB_TOPGEN   3392
#define XCD_BAR_WORDS 3456
#define XB_SPIN_CAP (1u << 18)

__device__ __forceinline__ unsigned xb_ld(unsigned* p)              { return __hip_atomic_load(p, __ATOMIC_RELAXED, __HIP_MEMORY_SCOPE_AGENT); }
__device__ __forceinline__ unsigned xb_add(unsigned* p, unsigned v) { return __hip_atomic_fetch_add(p, v, __ATOMIC_RELAXED, __HIP_MEMORY_SCOPE_AGENT); }
__device__ __forceinline__ unsigned xb_xcc_id() { return (unsigned)__builtin_amdgcn_s_getreg((3 << 11) | 20) & 0xFu; }
#define XB_SPIN(cond, bar) do { unsigned _sp = 0; while (cond) { __builtin_amdgcn_s_sleep(1); \
    if ((++_sp & 255u) == 0u) { if (xb_ld(&(bar)[XB_TMO])) break; if (_sp > XB_SPIN_CAP) { atomicAdd(&(bar)[XB_TMO], 1u); break; } } } } while (0)

struct XcdBarrier {
    unsigned* bar; unsigned x;
    volatile LAS unsigned* st;
};

__device__ __forceinline__ XcdBarrier xcd_barrier_post(unsigned* bar, volatile LAS unsigned* st) {
    XcdBarrier b; b.bar = bar; b.x = xb_xcc_id(); b.st = st;
    if (threadIdx.x == 0) (void)xb_add(&bar[XB_XCNT(b.x)], 1u);
    return b;
}
__device__ __forceinline__ void xcd_barrier_complete(unsigned* bar, unsigned x, unsigned& nloc, unsigned& nx) {
    const unsigned G = gridDim.x * gridDim.y * gridDim.z;
    unsigned sum, cnt, mine, sp = 0u;
    for (;;) {
        sum = 0u; cnt = 0u; mine = 0u;
#pragma unroll
        for (unsigned j = 0; j < 16; ++j) { const unsigned c = xb_ld(&bar[XB_XCNT(j)]); sum += c; cnt += (c > 0u) ? 1u : 0u; mine = (j == x) ? c : mine; }
        if (sum == G) break;
        __builtin_amdgcn_s_sleep(1);
        if ((++sp & 255u) == 0u) { if (xb_ld(&bar[XB_TMO])) break; if (sp > XB_SPIN_CAP) { atomicAdd(&bar[XB_TMO], 1u); break; } }
    }
    nloc = mine > 0u ? mine : 1u; nx = cnt > 0u ? cnt : 1u;
}

__device__ __forceinline__ void xcd_barrier(const XcdBarrier& b) {
    asm volatile("s_waitcnt vmcnt(0)" ::: "memory");
    __syncthreads();
    if (threadIdx.x == 0) {
        unsigned* bar = b.bar;
        __builtin_amdgcn_s_waitcnt(0);
        unsigned nloc = b.st[0], nx = b.st[1];
        if (nloc == 0u) { xcd_barrier_complete(bar, b.x, nloc, nx); b.st[0] = nloc; b.st[1] = nx; }
        const unsigned old = xb_add(&bar[XB_XSUB(b.x)], 1u);
        const unsigned gen = old / nloc;
        if (old + 1u == (gen + 1u) * nloc) {
            __builtin_amdgcn_fence(__ATOMIC_RELEASE, "agent");
            asm volatile("s_waitcnt vmcnt(0)" ::: "memory");
            const unsigned og = xb_add(&bar[XB_TOP], 1u);
            const unsigned tg = og / nx;
            if (og + 1u == (tg + 1u) * nx) xb_add(&bar[XB_TOPGEN], 1u);
            else XB_SPIN(xb_ld(&bar[XB_TOPGEN]) == tg, bar);
            __builtin_amdgcn_fence(__ATOMIC_ACQUIRE, "agent");
            xb_add(&bar[XB_XGEN(b.x)], 1u);
            asm volatile("s_waitcnt vmcnt(0)" ::: "memory");
        } else {
            XB_SPIN(xb_ld(&bar[XB_XGEN(b.x)]) == gen, bar);
            __builtin_amdgcn_fence(__ATOMIC_ACQUIRE, "agent");
            asm volatile("s_waitcnt vmcnt(0)" ::: "memory");
        }
    }
    __syncthreads();
}


__device__ __forceinline__ unsigned f2bf(float f) { unsigned u = __builtin_bit_cast(unsigned, f); return (u + 0x7fffu + ((u >> 16) & 1u)) >> 16; }
__device__ __forceinline__ unsigned pk2(float lo, float hi) { return pg8::cvt_pk_bf16(lo, hi); }
__device__ __forceinline__ float bflo(unsigned w) { return __uint_as_float(w << 16); }
__device__ __forceinline__ float bfhi(unsigned w) { return __uint_as_float(w & 0xffff0000u); }
__device__ __forceinline__ float wave_sum(float v) {
#pragma unroll
    for (int o = 1; o < 64; o <<= 1) v += __shfl_xor(v, o);
    return v;
}
__device__ __forceinline__ float gelu_tanh(float x) {
    const float u = x * (0.7978845608028654f + 0.035677408136300125f * x * x);
    return x * __builtin_amdgcn_rcpf(1.0f + __builtin_amdgcn_exp2f(-2.8853900817779268f * u));
}
__device__ __forceinline__ float silu_f(float x) { return x * __builtin_amdgcn_rcpf(1.0f + __builtin_amdgcn_exp2f(-1.4426950408889634f * x)); }

struct EpiInProj {
    static constexpr bool PERM = true, AFTER_DRAIN = false;
    unsigned char* wsb; const float *gq, *gk;
    __device__ __forceinline__ void operator()(const f32x4 (&acc)[2][2][4][2], const pg8::Unit& u, int wr, int wc, int fr, int fq) const {
        const int pm = u.pm, pn = u.pn;
        bf16* const Q = (bf16*)(wsb + WS_Q); bf16* const K = (bf16*)(wsb + WS_K); bf16* const V = (bf16*)(wsb + WS_V); bf16* const U = (bf16*)(wsb + WS_U); bf16* const VG = (bf16*)(wsb + WS_VG);
        float* const stats = (float*)(wsb + WS_STATS); const float* const ropec = (const float*)(wsb + WS_ROPE); const float* const ropes = ropec + 1024;
        const bool isctx = (pm % 17) == 0;
        const int seq0 = ((pm % 17) - 1) * 256;
        if (pn <= 2 && !(pn == 2 && wc >= 2)) {
            const bool isq = pn < 2;
            const float qscale = isq ? 0.125f * 1.4426950408889634f : 1.0f;
            const float* g = isq ? gq : gk;
            bf16* dst; int pitch, hcol;
            if (isq) { dst = Q; pitch = 512; hcol = (pn * 4 + wc) * 64; } else { dst = K; pitch = 128; hcol = wc * 64; }
            f32x4 gv[2][2];
#pragma unroll
            for (int bj = 0; bj < 2; ++bj)
#pragma unroll
                for (int n = 0; n < 2; ++n) gv[bj][n] = *(const f32x4*)(g + 32 * bj + 8 * fq + 4 * n);
            const int fbase = 8 * (fq & 1);
            const bool lowhalf = fq < 2;
#pragma unroll
            for (int ai = 0; ai < 2; ++ai)
#pragma unroll
                for (int m = 0; m < 4; ++m) {
                    const int rl = ai * 128 + wr * 64 + m * 16 + fr;
                    const int row = pm * 256 + rl;
                    float ss = 0.f;
#pragma unroll
                    for (int bj = 0; bj < 2; ++bj)
#pragma unroll
                        for (int n = 0; n < 2; ++n) { const f32x4 v = acc[ai][bj][m][n]; ss += (v[0] * v[0] + v[1] * v[1]) + (v[2] * v[2] + v[3] * v[3]); }
                    ss += __shfl_xor(ss, 16); ss += __shfl_xor(ss, 32);
                    const float rstd = __builtin_amdgcn_rsqf(ss * (1.0f / 64.0f) + EPS);
                    const int sp = seq0 + rl;
#pragma unroll
                    for (int bj = 0; bj < 2; ++bj) {
                        f32x4 y0 = acc[ai][bj][m][0] * (rstd * qscale) * gv[bj][0], y1 = acc[ai][bj][m][1] * (rstd * qscale) * gv[bj][1];
                        if (!isctx) {
                            const int pos = bj == 0 ? (sp >> 6) : (sp & 63);
                            const f32x4 c0 = *(const f32x4*)(ropec + pos * 16 + fbase), c1 = *(const f32x4*)(ropec + pos * 16 + fbase + 4);
                            const f32x4 s0 = *(const f32x4*)(ropes + pos * 16 + fbase), s1 = *(const f32x4*)(ropes + pos * 16 + fbase + 4);
                            f32x4 p0, p1;
#pragma unroll
                            for (int j = 0; j < 4; ++j) { p0[j] = __shfl_xor(y0[j], 32); p1[j] = __shfl_xor(y1[j], 32); }
                            if (lowhalf) { y0 = y0 * c0 - p0 * s0; y1 = y1 * c1 - p1 * s1; }
                            else         { y0 = p0 * s0 + y0 * c0; y1 = p1 * s1 + y1 * c1; }
                        }
                        u32x4 w; w.x = pk2(y0[0], y0[1]); w.y = pk2(y0[2], y0[3]); w.z = pk2(y1[0], y1[1]); w.w = pk2(y1[2], y1[3]);
                        *(u32x4*)(dst + (size_t)row * pitch + hcol + 32 * bj + 8 * fq) = w;
                    }
                }
        } else if (pn == 2) {
            const int hcol = (wc - 2) * 64;
#pragma unroll
            for (int ai = 0; ai < 2; ++ai)
#pragma unroll
                for (int m = 0; m < 4; ++m) {
                    const int row = pm * 256 + ai * 128 + wr * 64 + m * 16 + fr;
#pragma unroll
                    for (int bj = 0; bj < 2; ++bj) {
                        const f32x4 y0 = acc[ai][bj][m][0], y1 = acc[ai][bj][m][1];
                        u32x4 w; w.x = pk2(y0[0], y0[1]); w.y = pk2(y0[2], y0[3]); w.z = pk2(y1[0], y1[1]); w.w = pk2(y1[2], y1[3]);
                        *(u32x4*)(V + (size_t)row * 128 + hcol + 32 * bj + 8 * fq) = w;
                    }
                }
        } else {
            const bool isv = pn >= 5;
            bf16* dst = isv ? VG : U;
            const int cb = ((pn - (isv ? 5 : 3)) * 4 + wc) * 64;
#pragma unroll
            for (int ai = 0; ai < 2; ++ai)
#pragma unroll
                for (int m = 0; m < 4; ++m) {
                    const int row = pm * 256 + ai * 128 + wr * 64 + m * 16 + fr;
                    float s1 = 0.f, s2 = 0.f;
#pragma unroll
                    for (int bj = 0; bj < 2; ++bj) {
                        f32x4 y0 = acc[ai][bj][m][0], y1 = acc[ai][bj][m][1];
#pragma unroll
                        for (int j = 0; j < 4; ++j) { y0[j] = gelu_tanh(y0[j]); y1[j] = gelu_tanh(y1[j]); }
                        s1 += (y0[0] + y0[1]) + (y0[2] + y0[3]) + (y1[0] + y1[1]) + (y1[2] + y1[3]);
                        s2 += (y0[0] * y0[0] + y0[1] * y0[1]) + (y0[2] * y0[2] + y0[3] * y0[3]) + (y1[0] * y1[0] + y1[1] * y1[1]) + (y1[2] * y1[2] + y1[3] * y1[3]);
                        u32x4 w; w.x = pk2(y0[0], y0[1]); w.y = pk2(y0[2], y0[3]); w.z = pk2(y1[0], y1[1]); w.w = pk2(y1[2], y1[3]);
                        *(u32x4*)(dst + (size_t)row * 512 + cb + 32 * bj + 8 * fq) = w;
                    }
                    if (isv) {
                        s1 += __shfl_xor(s1, 16); s1 += __shfl_xor(s1, 32); s2 += __shfl_xor(s2, 16); s2 += __shfl_xor(s2, 32);
                        if (fq == 0) { float* sp = stats + (size_t)row * 16 + ((pn - 5) * 4 + wc) * 2; sp[0] = s1; sp[1] = s2; }
                    }
                }
        }
    }
};
struct EpiSwiglu {
    static constexpr bool PERM = true, AFTER_DRAIN = false;
    bf16* HID;
    __device__ __forceinline__ void operator()(const f32x4 (&acc)[2][2][4][2], const pg8::Unit& u, int wr, int wc, int fr, int fq) const {
#pragma unroll
        for (int ai = 0; ai < 2; ++ai)
#pragma unroll
            for (int m = 0; m < 4; ++m) {
                const int row = u.pm * 256 + ai * 128 + wr * 64 + m * 16 + fr;
                const f32x4 g0 = acc[ai][0][m][0], g1 = acc[ai][0][m][1], u0 = acc[ai][1][m][0], u1 = acc[ai][1][m][1];
                f32x4 y0, y1;
#pragma unroll
                for (int j = 0; j < 4; ++j) { y0[j] = silu_f(g0[j]) * u0[j]; y1[j] = silu_f(g1[j]) * u1[j]; }
                u32x4 w; w.x = pk2(y0[0], y0[1]); w.y = pk2(y0[2], y0[3]); w.z = pk2(y1[0], y1[1]); w.w = pk2(y1[2], y1[3]);
                *(u32x4*)(HID + (size_t)row * FFH + u.pn * 128 + wc * 32 + 8 * fq) = w;
            }
    }
};

struct RowOrder {
    pg8::StaticOrder b; int lat;
    __device__ __forceinline__ void init(int N, int G, int c, int latent_only) { lat = latent_only; b.init(latent_only ? NB * SEQ : M, N, G, c); }
    __device__ __forceinline__ bool next(int i, pg8::Unit& u) const { if (!b.next(i, u)) return false; if (lat) u.pm = u.pm + (u.pm >> 4) + 1; return true; }
    __device__ __forceinline__ void a_ready(const pg8::Unit&) const {}
    __device__ __forceinline__ void done(const pg8::Unit&) const {}
};

constexpr int CW_G3C = 3520;
struct G3Order {
    pg8::StaticOrder lat; int c; unsigned* cnt;
    __device__ __forceinline__ void init(int c_, unsigned* cnt_) { lat.init(NB * SEQ, FF2, 1, 0); c = c_; cnt = cnt_; }
    __device__ __forceinline__ bool next(int i, pg8::Unit& u) const {
        int idx;
        if (i < 10) idx = i * 256 + c;
        else { if (c < 32) return false; idx = 2560 + (c - 32) + (i - 10) * 224; if (idx >= 2992) return false; }
        if (idx < 176) { u.pm = 17 * (idx / 22); u.pn = idx % 22; }
        else { lat.next(idx - 176, u); u.pm = u.pm + (u.pm >> 4) + 1; }
        return true;
    }
    __device__ __forceinline__ void a_ready(const pg8::Unit&) const {}
    __device__ __forceinline__ void done(const pg8::Unit& u) const {
        if ((u.pm % 17) == 0) {
            __builtin_amdgcn_fence(__ATOMIC_RELEASE, "agent");
            asm volatile("s_waitcnt vmcnt(0)" ::: "memory");
            if ((threadIdx.x & 63) == 0) __hip_atomic_fetch_add(cnt, 1u, __ATOMIC_RELAXED, __HIP_MEMORY_SCOPE_AGENT);
        }
    }
};
struct CtxOneOrder {
    int c; unsigned* cnt; unsigned need;
    __device__ __forceinline__ bool next(int i, pg8::Unit& u) const { if (i != 0) return false; u.pm = 17 * (c >> 2); u.pn = c & 3; return true; }
    __device__ __forceinline__ void a_ready(const pg8::Unit&) const {
        unsigned sp = 0;
        while ((unsigned)__builtin_amdgcn_readfirstlane(__hip_atomic_load(cnt, __ATOMIC_RELAXED, __HIP_MEMORY_SCOPE_AGENT)) < need) { __builtin_amdgcn_s_sleep(4); if (++sp > (1u << 22)) break; }
        __builtin_amdgcn_fence(__ATOMIC_ACQUIRE, "agent");
        asm volatile("s_waitcnt vmcnt(0)" ::: "memory");
    }
    __device__ __forceinline__ void done(const pg8::Unit&) const {}
};

namespace att {
constexpr int D = 64, QBLK = 32, KVBLK = 64;
constexpr float SCALE = 0.125f, THR = 8.f;
constexpr int SHM_T = KVBLK * D * 2;
constexpr int NSLOT = 4, OFF_V = 0, OFF_K = NSLOT * SHM_T, OFF_WS = 2 * NSLOT * SHM_T, OFF_OST = OFF_WS + NWAVES * 64 * 4, SHM_ATTN = OFF_OST + NWAVES * 4096;
#define SBAR() __builtin_amdgcn_sched_barrier(0)
#define KSWZ(s, colB) ((s) * 256 + ((colB) ^ (((s) & 7) << 4)))
__device__ __forceinline__ int crow(int r, int hi) { return (r & 3) + 8 * (r >> 2) + 4 * hi; }
__device__ __forceinline__ unsigned cvtpk(float lo, float hi) { unsigned r; asm volatile("v_cvt_pk_bf16_f32 %0, %1, %2" : "=v"(r) : "v"(lo), "v"(hi)); return r; }

__device__ __forceinline__ void partialSM(f32x16& p0) {
#pragma unroll
    for (int r = 0; r < 16; ++r) p0[r] = __builtin_amdgcn_exp2f(p0[r]);
}
__device__ __forceinline__ void finishSM(f32x16& p0, f32x16& p1, float& l_reg, bf16x8& pa0, bf16x8& pa1, bf16x8& pa2, bf16x8& pa3) {
#pragma unroll
    for (int r = 0; r < 16; ++r) p1[r] = __builtin_amdgcn_exp2f(p1[r]);
    float ps = p0[0];
#pragma unroll
    for (int r = 1; r < 16; ++r) ps += p0[r];
#pragma unroll
    for (int r = 0; r < 16; ++r) ps += p1[r];
    l_reg += ps;
#define PK4(P, BASE, OUT) do { unsigned a0 = cvtpk(P[BASE + 0], P[BASE + 1]), a1 = cvtpk(P[BASE + 2], P[BASE + 3]);   \
    unsigned b0 = cvtpk(P[BASE + 4], P[BASE + 5]), b1 = cvtpk(P[BASE + 6], P[BASE + 7]);                              \
    u32x4 w = {a0, a1, b0, b1}; OUT = *reinterpret_cast<bf16x8*>(&w); } while (0)
    PK4(p0, 0, pa0); PK4(p0, 8, pa1); PK4(p1, 0, pa2); PK4(p1, 8, pa3);
#undef PK4
}
__device__ __forceinline__ void qkt(f32x16& p0, f32x16& p1, const char* Ks, const bf16x8* qr, const f32x16& negm, int r32, int hi) {
#pragma unroll
    for (int d0 = 0; d0 < 4; ++d0) { const int cb = (d0 * 16 + hi * 8) * 2;
        const bf16x8 b0 = *reinterpret_cast<const bf16x8*>(Ks + KSWZ(r32, cb));
        const bf16x8 b1 = *reinterpret_cast<const bf16x8*>(Ks + KSWZ(r32, 128 + cb));
        if (d0 == 0) { p0 = __builtin_amdgcn_mfma_f32_32x32x16_bf16(b0, qr[0], negm, 0, 0, 0); p1 = __builtin_amdgcn_mfma_f32_32x32x16_bf16(b1, qr[0], negm, 0, 0, 0); }
        else { p0 = __builtin_amdgcn_mfma_f32_32x32x16_bf16(b0, qr[d0], p0, 0, 0, 0); p1 = __builtin_amdgcn_mfma_f32_32x32x16_bf16(b1, qr[d0], p1, 0, 0, 0); } }
}
__device__ __forceinline__ int v_st(int k, int c) { const int kk = (k & ~0xC) | ((k & 4) << 1) | ((k & 8) >> 1); return ((kk >> 3) * 2 + (c >> 5)) * 512 + ((kk & 7) * 32 + (c & 31)) * 2; }
__device__ __forceinline__ int v_rd_base(int lane) { return (((lane & 3) << 3) | (((lane >> 2) & 3) << 6) | (((lane >> 4) & 1) << 5)) + ((lane >> 5) & 1) * 1024; }
constexpr int v_rd_off(int d0, int ks, int half) { return d0 * 512 + ks * 2048 + half * 256; }
typedef short v4i16_t __attribute__((ext_vector_type(4)));
template <int OFF> __device__ __forceinline__ s16x4 tr_read(int vb) {
    return __builtin_bit_cast(s16x4, __builtin_amdgcn_ds_read_tr16_b64_v4i16((LAS v4i16_t*)(unsigned)(vb + OFF)));
}
template <int D0> __device__ __forceinline__ void pv_one(f32x16& od, int vb, bf16x8 pa0, bf16x8 pa1, bf16x8 pa2, bf16x8 pa3) {
    const s16x4 l0 = tr_read<v_rd_off(D0, 0, 0)>(vb), h0 = tr_read<v_rd_off(D0, 0, 1)>(vb), l1 = tr_read<v_rd_off(D0, 1, 0)>(vb), h1 = tr_read<v_rd_off(D0, 1, 1)>(vb);
    const s16x4 l2 = tr_read<v_rd_off(D0, 2, 0)>(vb), h2 = tr_read<v_rd_off(D0, 2, 1)>(vb), l3 = tr_read<v_rd_off(D0, 3, 0)>(vb), h3 = tr_read<v_rd_off(D0, 3, 1)>(vb);
#define PK(L, H) (bf16x8){L[0], L[1], L[2], L[3], H[0], H[1], H[2], H[3]}
    od = __builtin_amdgcn_mfma_f32_32x32x16_bf16(pa0, PK(l0, h0), od, 0, 0, 0);
    od = __builtin_amdgcn_mfma_f32_32x32x16_bf16(pa1, PK(l1, h1), od, 0, 0, 0);
    od = __builtin_amdgcn_mfma_f32_32x32x16_bf16(pa2, PK(l2, h2), od, 0, 0, 0);
    od = __builtin_amdgcn_mfma_f32_32x32x16_bf16(pa3, PK(l3, h3), od, 0, 0, 0);
#undef PK
}
__device__ __forceinline__ void pv_d0(f32x16* o, int vb, bf16x8 pa0, bf16x8 pa1, bf16x8 pa2, bf16x8 pa3) {
    pv_one<0>(o[0], vb, pa0, pa1, pa2, pa3); pv_one<1>(o[1], vb, pa0, pa1, pa2, pa3);
}
constexpr int LDQ = 512, LDK = 128, LDO = 1024;
__device__ __forceinline__ void attn_body(const bf16* __restrict__ Qb, const bf16* __restrict__ Kh, const bf16* __restrict__ Vh, bf16* __restrict__ Ob, int seq, float m0l2, char* lds, bool pre, bool post) {
    const int tid = tid_fresh(), wid = tid >> 6, lane = tid & 63, r32 = lane & 31, hi = lane >> 5;
    char* V_lds = lds + OFF_V; char* K_lds = lds + OFF_K;
    float* li_l = (float*)(lds + OFF_WS) + wid * 64;
    float l_reg = 0; f32x16 o[2] = {}; bf16x8 qr[4];
    f32x16 negm;
#pragma unroll
    for (int r = 0; r < 16; ++r) negm[r] = -m0l2;
    asm volatile("" : "+v"(negm));
    const bf16* Qw = Qb + (long)(wid * QBLK + r32) * LDQ + hi * 8;
#pragma unroll
    for (int d0 = 0; d0 < 4; ++d0) qr[d0] = __builtin_nontemporal_load(reinterpret_cast<const bf16x8*>(Qw + d0 * 16));
    const int wsg = __builtin_amdgcn_readfirstlane(wid);
    const int oo = (wsg * 64 + lane) * 16;
    const int ksr = oo >> 8, kcolB = (oo & 255) ^ ((ksr & 7) << 4);
    const bf16* kptr = Kh + (long)(ksr + 32 * (kcolB >> 7)) * LDK + ((kcolB & 127) >> 1);
    const int vkk = ((oo >> 9) >> 1) * 8 + ((oo & 511) >> 6), vcc = ((oo >> 9) & 1) * 32 + ((oo & 63) >> 1);
    const bf16* vptr = Vh + (long)((vkk & ~0xC) | ((vkk & 4) << 1) | ((vkk & 8) >> 1)) * LDK + vcc;
    LAS unsigned char* const ldsK = (LAS unsigned char*)lds + OFF_K + wsg * 1024; LAS unsigned char* const ldsV = (LAS unsigned char*)lds + OFF_V + wsg * 1024;
    const int vb0 = (int)(uintptr_t)V_lds + v_rd_base(lane);
    const int NT = seq / KVBLK;
#define SLOT(t) (((t) & 3) << 13)
#define DMA(t) do { const int t_ = (t) < NT ? (t) : NT - 1; const long off_ = (long)t_ * (KVBLK * LDK); \
        __builtin_amdgcn_global_load_lds((const unsigned*)(kptr + off_), (LAS unsigned*)(ldsK + SLOT(t)), 16, 0, 0); \
        __builtin_amdgcn_global_load_lds((const unsigned*)(vptr + off_), (LAS unsigned*)(ldsV + SLOT(t)), 16, 0, 0); } while (0)
#define WBAR(N) asm volatile("s_waitcnt vmcnt(" #N ") lgkmcnt(0)\n\ts_barrier" ::: "memory")
    f32x16 pA0, pA1, pB0, pB1; bf16x8 pa0, pa1, pa2, pa3;
#define HALF(PX0, PX1, PY0, PY1, j_, MORE) do { \
        SBAR(); if (MORE) DMA((j_) + 2); qkt(PX0, PX1, K_lds + SLOT(j_), qr, negm, r32, hi); \
        finishSM(PY0, PY1, l_reg, pa0, pa1, pa2, pa3); SBAR(); \
        pv_d0(o, vb0 + SLOT((j_) - 1), pa0, pa1, pa2, pa3); partialSM(PX0); \
        if (MORE) WBAR(2); else WBAR(0); } while (0)
    if (!pre) { DMA(0); DMA(1); } DMA(2); WBAR(2);
    qkt(pA0, pA1, K_lds, qr, negm, r32, hi); partialSM(pA0);
    int j = 1;
    for (; j + 4 < NT; j += 2) {
        HALF(pB0, pB1, pA0, pA1, j, true);
        HALF(pA0, pA1, pB0, pB1, j + 1, true);
    }
    HALF(pB0, pB1, pA0, pA1, j, true);
    HALF(pA0, pA1, pB0, pB1, j + 1, false);
    if (post) { DMA(0); DMA(1); }
    SBAR(); qkt(pB0, pB1, K_lds + SLOT(NT - 1), qr, negm, r32, hi);
    finishSM(pA0, pA1, l_reg, pa0, pa1, pa2, pa3); SBAR();
    pv_d0(o, vb0 + SLOT(NT - 2), pa0, pa1, pa2, pa3); partialSM(pB0);
    finishSM(pB0, pB1, l_reg, pa0, pa1, pa2, pa3); SBAR();
    pv_d0(o, vb0 + SLOT(NT - 1), pa0, pa1, pa2, pa3);
    { auto rr = __builtin_amdgcn_permlane32_swap(__float_as_uint(l_reg), __float_as_uint(l_reg), false, false); l_reg = __uint_as_float(rr[0]) + __uint_as_float(rr[1]); }
    if (hi == 0) li_l[r32] = l_reg; asm volatile("s_waitcnt lgkmcnt(0)" ::: "memory");
    float rli[16];
#pragma unroll
    for (int r = 0; r < 16; ++r) rli[r] = __builtin_amdgcn_rcpf(li_l[crow(r, hi)]);
    bf16* Ow = Ob + (long)(wid * QBLK) * LDO;
    {
        bf16* stg = (bf16*)(lds + OFF_OST) + wid * 2048;
#pragma unroll
        for (int r = 0; r < 16; ++r) { const int orow = crow(r, hi);
#pragma unroll
            for (int d0 = 0; d0 < 2; ++d0) stg[orow * 64 + d0 * 32 + r32] = (bf16)f2bf(o[d0][r] * rli[r]); }
        asm volatile("s_waitcnt lgkmcnt(0)" ::: "memory");
#pragma unroll
        for (int i = 0; i < 4; ++i) { const int row = i * 8 + (lane >> 3), ch = lane & 7; const u32x4 v = *(const u32x4*)(stg + row * 64 + ch * 8); *(u32x4*)(Ow + (long)row * LDO + ch * 8) = v; }
    }
    asm volatile("s_waitcnt vmcnt(0)" ::: "memory");
    __syncthreads();
#undef HALF
#undef DMA
#undef WBAR
#undef SLOT
}
#undef SBAR
}

constexpr int GT_PITCH = 136;
struct GateRegs { u32x4 v0, v1; f32x4 sa, sb, sc, sd; u32x2 uu[4]; bf16x8 wf[8]; };
__device__ __forceinline__ void gate_phase(int bx, int G, bool skip_ctx, const bf16* __restrict__ VG, const bf16* __restrict__ U, const float* __restrict__ stats,
                                           const float* __restrict__ gsg, const float* __restrict__ bsg, const bf16* __restrict__ Wl, const float* __restrict__ bsl,
                                           bf16* __restrict__ MIX, char* lds) {
    const int tid = tid_fresh(), wid = tid >> 6, lane = tid & 63, r32 = lane & 31, hi = lane >> 5;
    bf16* T = (bf16*)lds;
    const int q = tid >> 2, dc = (tid & 3) * 16;
    const int db = wid & 1, pb = wid >> 1, p = pb * 32 + r32;
    const int NU = (M / 128) * 8;
    auto unit_ok = [&](int u) { return u < NU && !(skip_ctx && ((u >> 3) % 34) < 2); };
    auto next_unit = [&](int u) { u += G; while (u < NU && !unit_ok(u)) u += G; return u; };
    int u = bx; if (!unit_ok(u)) u = next_unit(u);
    GateRegs R;
#define GATE_LOAD(uu_) do { const int chunk_ = (uu_) >> 3, h_ = (uu_) & 7; const size_t rq = (size_t)chunk_ * 128 + q; \
        const float* st_ = stats + rq * 16; R.sa = *(const f32x4*)st_; R.sb = *(const f32x4*)(st_ + 4); R.sc = *(const f32x4*)(st_ + 8); R.sd = *(const f32x4*)(st_ + 12); \
        R.v0 = __builtin_nontemporal_load((const u32x4*)(VG + rq * 512 + h_ * 64 + dc)); R.v1 = __builtin_nontemporal_load((const u32x4*)(VG + rq * 512 + h_ * 64 + dc + 8)); \
        const size_t rp = (size_t)chunk_ * 128 + p; \
        _Pragma("unroll") for (int g4 = 0; g4 < 4; ++g4) R.uu[g4] = __builtin_nontemporal_load((const u32x2*)(U + rp * 512 + h_ * 64 + db * 32 + 8 * g4 + 4 * hi)); \
        const bf16* wrow_ = Wl + ((size_t)h_ * 128 + p) * 128 + hi * 8; \
        _Pragma("unroll") for (int ks = 0; ks < 8; ++ks) R.wf[ks] = *(const bf16x8*)(wrow_ + ks * 16); } while (0)
    if (u < NU) GATE_LOAD(u);
    while (u < NU) {
        const int chunk = u >> 3, h = u & 7;
        {
            const float s1 = (R.sa[0] + R.sa[2]) + (R.sb[0] + R.sb[2]) + (R.sc[0] + R.sc[2]) + (R.sd[0] + R.sd[2]);
            const float s2 = (R.sa[1] + R.sa[3]) + (R.sb[1] + R.sb[3]) + (R.sc[1] + R.sc[3]) + (R.sd[1] + R.sd[3]);
            const float mean = s1 * (1.0f / 512.0f);
            const float var = fmaxf(s2 * (1.0f / 512.0f) - mean * mean, 0.f);
            const float rstd = __builtin_amdgcn_rsqf(var + EPS);
            const float* gp = gsg + h * 64 + dc; const float* bp = bsg + h * 64 + dc;
#pragma unroll
            for (int i = 0; i < 8; ++i) {
                const unsigned w = i < 4 ? R.v0[i] : R.v1[i - 4];
                const float x0 = (bflo(w) - mean) * rstd * gp[2 * i] + bp[2 * i], x1 = (bfhi(w) - mean) * rstd * gp[2 * i + 1] + bp[2 * i + 1];
                T[(dc + 2 * i) * GT_PITCH + q] = (bf16)f2bf(x0); T[(dc + 2 * i + 1) * GT_PITCH + q] = (bf16)f2bf(x1);
            }
        }
        u32x2 ucur[4]; bf16x8 wcur[8];
#pragma unroll
        for (int g4 = 0; g4 < 4; ++g4) ucur[g4] = R.uu[g4];
#pragma unroll
        for (int ks = 0; ks < 8; ++ks) wcur[ks] = R.wf[ks];
        const float bias = bsl[h * 128 + p];
        const int un = next_unit(u);
        if (un < NU) GATE_LOAD(un);
        __syncthreads();
        f32x16 acc = {};
        const bf16* trow = T + (db * 32 + r32) * GT_PITCH + hi * 8;
#pragma unroll
        for (int ks = 0; ks < 8; ++ks) {
            const bf16x8 av = *(const bf16x8*)(trow + ks * 16);
            acc = __builtin_amdgcn_mfma_f32_32x32x16_bf16(av, wcur[ks], acc, 0, 0, 0);
        }
        const size_t row = (size_t)chunk * 128 + p;
#pragma unroll
        for (int g4 = 0; g4 < 4; ++g4) {
            const int d0 = db * 32 + 8 * g4 + 4 * hi;
            u32x2 w;
            w.x = pk2(bflo(ucur[g4].x) * (acc[4 * g4 + 0] + bias), bfhi(ucur[g4].x) * (acc[4 * g4 + 1] + bias));
            w.y = pk2(bflo(ucur[g4].y) * (acc[4 * g4 + 2] + bias), bfhi(ucur[g4].y) * (acc[4 * g4 + 3] + bias));
            *(u32x2*)(MIX + row * 1024 + 512 + h * 64 + d0) = w;
        }
        __syncthreads();
        u = un;
    }
#undef GATE_LOAD
}

struct RowPass { const float* x_in; const float* ctx_in; float* out; float* xc; const bf16* Y; bf16* H; const float* mod;
                 const float* gpost; const float* gpre; int init, update, norm_out, lg, gi, ln, si, skip_ctx; };
__device__ __forceinline__ void row_pass(const RowPass& R, int gw, int ngw, int lane) {
    constexpr int NR = 2;
    for (int row0 = gw; row0 < M; row0 += NR * ngw) {
        f32x4 v[NR][4]; u32x2 yw[NR][4]; bool act[NR]; float* xrow[NR]; int bbs[NR];
#pragma unroll
        for (int k = 0; k < NR; ++k) {
            const int row = row0 + k * ngw;
            const int rowc = row < M ? row : row0;
            const int b = rowc / RPB, i = rowc - b * RPB; const bool isctx = i < CTXL;
            act[k] = (row < M) && !(isctx && R.skip_ctx);
            bbs[k] = isctx ? 8 : b;
            xrow[k] = isctx ? R.xc + ((size_t)b * CTXL + i) * DM : R.out + ((size_t)b * SEQ + (i - CTXL)) * DM;
            const float* src = R.init ? (isctx ? R.ctx_in + ((size_t)b * CTXL + i) * DM : R.x_in + ((size_t)b * SEQ + (i - CTXL)) * DM) : xrow[k];
            if (act[k]) {
#pragma unroll
                for (int j = 0; j < 4; ++j) v[k][j] = __builtin_nontemporal_load((const f32x4*)(src + lane * 4 + 256 * j));
                if (R.update) { const bf16* yr = R.Y + (size_t)rowc * DM;
#pragma unroll
                    for (int j = 0; j < 4; ++j) yw[k][j] = __builtin_nontemporal_load((const u32x2*)(yr + lane * 4 + 256 * j)); }
            }
        }
#pragma unroll
        for (int k = 0; k < NR; ++k) {
            if (!act[k]) continue;
            const int row = row0 + k * ngw, bb = bbs[k];
            if (R.update) {
                f32x4 y[4]; float ss = 0.f;
#pragma unroll
                for (int j = 0; j < 4; ++j) { const u32x2 w = yw[k][j]; y[j] = (f32x4){bflo(w.x), bfhi(w.x), bflo(w.y), bfhi(w.y)};
                    ss += (y[j][0] * y[j][0] + y[j][1] * y[j][1]) + (y[j][2] * y[j][2] + y[j][3] * y[j][3]); }
                const float rstd = __builtin_amdgcn_rsqf(wave_sum(ss) * (1.0f / DM) + EPS);
                const float* gate = R.mod + ((size_t)(R.lg * 9 + bb) * NMOD + R.gi) * DM;
#pragma unroll
                for (int j = 0; j < 4; ++j) { const f32x4 g = *(const f32x4*)(gate + lane * 4 + 256 * j), gp = *(const f32x4*)(R.gpost + lane * 4 + 256 * j);
                    v[k][j] = v[k][j] + g * (y[j] * rstd * gp); }
            }
            if (R.init || R.update) {
#pragma unroll
                for (int j = 0; j < 4; ++j) __builtin_nontemporal_store(v[k][j], (f32x4*)(xrow[k] + lane * 4 + 256 * j));
            }
            if (R.norm_out) {
                float ss = 0.f;
#pragma unroll
                for (int j = 0; j < 4; ++j) ss += (v[k][j][0] * v[k][j][0] + v[k][j][1] * v[k][j][1]) + (v[k][j][2] * v[k][j][2] + v[k][j][3] * v[k][j][3]);
                const float rstd = __builtin_amdgcn_rsqf(wave_sum(ss) * (1.0f / DM) + EPS);
                const float* shift = R.mod + ((size_t)(R.ln * 9 + bb) * NMOD + R.si) * DM; const float* scale = shift + DM;
                bf16* hr = R.H + (size_t)row * DM;
#pragma unroll
                for (int j = 0; j < 4; ++j) { const f32x4 gp = *(const f32x4*)(R.gpre + lane * 4 + 256 * j), sh = *(const f32x4*)(shift + lane * 4 + 256 * j), sc = *(const f32x4*)(scale + lane * 4 + 256 * j);
                    const f32x4 hv = (v[k][j] * rstd * gp) * (sc + 1.0f) + sh;
                    u32x2 w; w.x = pk2(hv[0], hv[1]); w.y = pk2(hv[2], hv[3]); *(u32x2*)(hr + lane * 4 + 256 * j) = w; }
            }
        }
    }
}

__device__ __forceinline__ int rowmap(int mode, int n0) {
    if (mode == 1) { const int pn = n0 >> 8, q = n0 & 255; return pn * 256 + 128 * ((q & 63) >> 5) + 32 * (q >> 6); }
    if (mode == 2) { const int bj = n0 >= FFH ? 1 : 0, r = n0 - bj * FFH; return (r >> 7) * 256 + bj * 128 + (r & 127); }
    return n0;
}
__device__ __forceinline__ void transpose_item(const float* __restrict__ W, int K, int N, bf16* __restrict__ WT, int mode, LAS float* scr, int item, int lane) {
    const int nblk = N / 32, kb = item / nblk, nb = item % nblk, k0 = 64 * kb, n0 = 32 * nb;
#pragma unroll 8
    for (int i = 0; i < 32; ++i) { const int kk = 2 * i + (lane >> 5); scr[kk * 33 + (lane & 31)] = __builtin_nontemporal_load(W + (size_t)(k0 + kk) * N + n0 + (lane & 31)); }
    asm volatile("s_waitcnt lgkmcnt(0)" ::: "memory");
    const int c = lane & 7; const int r0 = rowmap(mode, n0);
#pragma unroll
    for (int j = 0; j < 4; ++j) { const int n = (lane >> 3) + 8 * j; const LAS float* s = scr + (8 * c) * 33 + n;
        u32x4 o; o.x = pk2(s[0 * 33], s[1 * 33]); o.y = pk2(s[2 * 33], s[3 * 33]); o.z = pk2(s[4 * 33], s[5 * 33]); o.w = pk2(s[6 * 33], s[7 * 33]);
        *(u32x4*)(WT + (size_t)(r0 + n) * K + k0 + 8 * c) = o; }
    asm volatile("s_waitcnt lgkmcnt(0)" ::: "memory");
}

__device__ __forceinline__ void convert_weights(ArgP A, unsigned char* lds_g, int gw, int NGW, int l0, int l1, int lane, int wave) {
    unsigned char* ws = A->ws;
    LAS float* scr = (LAS float*)((LAS unsigned char*)lds_g + wave * 8704);
    constexpr int I_IN = (DM / 64) * (INW / 32), I_OUT = (DM / 64) * (DM / 32), I_F1 = (DM / 64) * (FF2 / 32), I_F2 = (FFH / 64) * (DM / 32);
    constexpr int PER_L = I_IN + I_OUT + I_F1 + I_F2;
    for (int it = l0 * PER_L + gw; it < l1 * PER_L; it += NGW) {
        const int l = it / PER_L; int r = it - l * PER_L;
        if (r < I_IN) { transpose_item(A->w_in + (size_t)l * DM * INW, DM, INW, (bf16*)(ws + WS_WIN) + (size_t)l * INW * DM, 1, scr, r, lane); continue; } r -= I_IN;
        if (r < I_OUT) { transpose_item(A->w_out + (size_t)l * DM * DM, DM, DM, (bf16*)(ws + WS_WOUT) + (size_t)l * DM * DM, 0, scr, r, lane); continue; } r -= I_OUT;
        if (r < I_F1) { transpose_item(A->w_ffn_in + (size_t)l * DM * FF2, DM, FF2, (bf16*)(ws + WS_WF1) + (size_t)l * FF2 * DM, 2, scr, r, lane); continue; } r -= I_F1;
        transpose_item(A->w_ffn_out + (size_t)l * FFH * DM, FFH, DM, (bf16*)(ws + WS_WF2) + (size_t)l * DM * FFH, 0, scr, r, lane);
    }
}
__device__ __forceinline__ void prologue(ArgP A, unsigned char* lds_g, int vcu, int G) {
    const int tid = tid_fresh(), lane = tid & 63, wave = tid >> 6;
    unsigned char* ws = A->ws;
    convert_weights(A, lds_g, vcu * NWAVES + wave, G * NWAVES, 0, G == 256 ? 1 : DEPTH, lane, wave);
    {
        const int gt = vcu * NTHR + tid, NGT = G * NTHR;
        const int n4 = DEPTH * 8 * 128 * 128 / 4;
        bf16* wsb = (bf16*)(ws + WS_WS);
        for (int i = gt; i < n4; i += NGT) { const f32x4 v = *(const f32x4*)(A->w_s + (size_t)i * 4); u32x2 w; w.x = pk2(v[0], v[1]); w.y = pk2(v[2], v[3]); *(u32x2*)(wsb + (size_t)i * 4) = w; }
        if (gt < 1024) { const int pos = gt >> 4, f = gt & 15; const float inv = __builtin_amdgcn_exp2f(-(float)f * (13.287712379549449f / 16.0f)); const float ang = (float)pos * inv;
            float* rc = (float*)(ws + WS_ROPE); rc[gt] = __cosf(ang); rc[1024 + gt] = __sinf(ang); }
    }
    __syncthreads();
    {
        float* sil = (float*)lds_g;
        float* red = (float*)lds_g + 9 * 1024;
        for (int i = tid; i < 9 * 1024; i += NTHR) { const float cv = i < 8 * 1024 ? A->c[i] : A->c_ctx[i - 8 * 1024]; sil[i] = cv / (1.0f + __expf(-cv)); }
        __syncthreads();
        const int kg = tid >> 6, n = tid & 63;
        constexpr int NU = DEPTH * (NMOD * DM / 64);
        for (int un = vcu; un < NU; un += G) {
            const int l = un / (NMOD * DM / 64), cb = (un % (NMOD * DM / 64)) * 64;
            const float* wp = A->w_mod + ((size_t)l * DM + kg * 128) * (NMOD * DM) + cb + n;
            float acc[9];
#pragma unroll
            for (int bb = 0; bb < 9; ++bb) acc[bb] = 0.f;
#pragma unroll 2
            for (int k = 0; k < 128; k += 4) {
                const float w0 = __builtin_nontemporal_load(wp + (size_t)(k + 0) * (NMOD * DM)), w1 = __builtin_nontemporal_load(wp + (size_t)(k + 1) * (NMOD * DM)), w2 = __builtin_nontemporal_load(wp + (size_t)(k + 2) * (NMOD * DM)), w3 = __builtin_nontemporal_load(wp + (size_t)(k + 3) * (NMOD * DM));
#pragma unroll
                for (int bb = 0; bb < 9; ++bb) { const f32x4 s = *(const f32x4*)(sil + bb * 1024 + kg * 128 + k); acc[bb] += (s[0] * w0 + s[1] * w1) + (s[2] * w2 + s[3] * w3); }
            }
#pragma unroll
            for (int bb = 0; bb < 9; ++bb) red[(kg * 9 + bb) * 64 + n] = acc[bb];
            __syncthreads();
            for (int o = tid; o < 9 * 64; o += NTHR) { const int bb = o >> 6, nn = o & 63; float s = 0.f;
#pragma unroll
                for (int g = 0; g < 8; ++g) s += red[(g * 9 + bb) * 64 + nn];
                ((float*)(ws + WS_MOD))[((size_t)(l * 9 + bb)) * (NMOD * DM) + cb + nn] = s + A->b_mod[(size_t)l * NMOD * DM + cb + nn]; }
            __syncthreads();
        }
    }
}

constexpr int N_PHASES = 2 + 7 * DEPTH;
__global__ void __launch_bounds__(NTHR, 2) fwd_kernel(Args A_) {
    extern __shared__ __attribute__((aligned(16))) unsigned char lds[];
    cg::grid_group grid = cg::this_grid();
    const int G = gridDim.x, bx = blockIdx.x;
    volatile LAS unsigned* MISC = (volatile LAS unsigned*)((LAS unsigned char*)lds + LDS_STAGE);
    if (threadIdx.x < 8) MISC[threadIdx.x] = 0u;
    __syncthreads();
    (void)xcd_barrier_post((unsigned*)(A_.ws + WS_BAR), MISC);
    const int vcu = (G % 8 == 0) ? (bx % 8) * (G / 8) + bx / 8 : bx;
#ifndef PROBE_DUP
#define PROBE_DUP 0
#endif
#pragma unroll 1
    for (int st = A_.ph_lo * 2; st < A_.ph_hi * 2; ++st) {
        const int ph = st >> 1;
        ArgP A = (ArgP)__builtin_amdgcn_kernarg_segment_ptr(); asm volatile("" : "+s"(A));
        {
            const int ptype = ph == 0 ? 0 : ph == 1 ? 7 : 1 + (ph - 2) % 7;
            if ((st & 1) && !((PROBE_DUP >> ptype) & 1) && !((PROBE_DUP >> 8) & 1)) continue;
        }
        const int tid = tid_fresh(), lane = tid & 63, wave = __builtin_amdgcn_readfirstlane(tid >> 6);
        const int gw = vcu * NWAVES + wave, ngw = G * NWAVES;
        unsigned char* const ws = A->ws;
        bf16* const Hb = (bf16*)(ws + WS_H); bf16* const Yb = (bf16*)(ws + WS_Y); bf16* const HIDb = (bf16*)(ws + WS_BIG);
        bf16* const Qb = (bf16*)(ws + WS_Q); bf16* const Kb = (bf16*)(ws + WS_K); bf16* const Vb = (bf16*)(ws + WS_V); bf16* const Ub = (bf16*)(ws + WS_U); bf16* const VGb = (bf16*)(ws + WS_VG); bf16* const MIXb = (bf16*)(ws + WS_MIX);
        float* const modp = (float*)(ws + WS_MOD); float* const statp = (float*)(ws + WS_STATS); float* const xc = (float*)(ws + WS_XC);
        if ((st & 1) && ((PROBE_DUP >> 8) & 1)) {
        } else
        if (ph == 0) {
            prologue(A, lds, vcu, G);
        } else if (ph == 1) {
            RowPass R{A->x, A->ctx, A->out, xc, nullptr, Hb, modp, nullptr, A->g_pre_mix, 1, 0, 1, 0, 0, 0, 0, 0};
            row_pass(R, gw, ngw, lane);
        } else {
            const int l = (ph - 2) / 7, s = (ph - 2) % 7;
            if (s == 0) {
                pg8::Gemm g{Hb, (const bf16*)(ws + WS_WIN) + (size_t)l * INW * DM, M, INW, DM}; RowOrder S; S.init(INW, G, bx, 0);
                EpiInProj E{ws, A->g_q + l * 64, A->g_k + l * 64};
                pg8::gemm_phase<EpiInProj, RowOrder, true, true>((LAS unsigned char*)lds, g, S, E);
            } else if (s == 1) {
                const bool lastl = (l == DEPTH - 1);
                float gqm = fabsf(A->g_q[l * 64 + lane]), gkm = fabsf(A->g_k[l * 64 + lane]);
#pragma unroll
                for (int o = 1; o < 64; o <<= 1) { gqm = fmaxf(gqm, __shfl_xor(gqm, o)); gkm = fmaxf(gkm, __shfl_xor(gkm, o)); }
                const float m0l2 = 8.0f * 1.4426950408889634f * gqm * gkm;
                const bool chain = (G == 256);
                const bool hasctx = bx < 64 && !lastl;
                for (int i = 0; ; ++i) {
                    const int u = bx + i * G; if (u >= NB * 16 * 8) break;
                    const int b = u & 7, rest = u >> 3, h = rest & 7, qb = rest >> 3;
                    const size_t r0 = (size_t)b * RPB;
                    const bool more = (u + G < NB * 16 * 8) || hasctx;
                    att::attn_body(Qb + (r0 + CTXL + qb * 256) * 512 + h * 64, Kb + r0 * 128 + (h >> 2) * 64, Vb + r0 * 128 + (h >> 2) * 64,
                                   MIXb + (r0 + CTXL + qb * 256) * 1024 + h * 64, RPB, m0l2, (char*)lds, chain && i > 0, chain && more);
                }
                if (hasctx) {
                    const int b = bx & 7, h = bx >> 3; const size_t r0 = (size_t)b * RPB;
                    att::attn_body(Qb + r0 * 512 + h * 64, Kb + r0 * 128 + (h >> 2) * 64, Vb + r0 * 128 + (h >> 2) * 64, MIXb + r0 * 1024 + h * 64, CTXL, m0l2, (char*)lds, chain, false);
                }
                for (int grep_ = 0; grep_ < (((PROBE_DUP >> 9) & 1) ? 2 : 1); ++grep_)
                    gate_phase(bx, G, lastl, VGb, Ub, statp, A->g_sg + l * 512, A->b_sg + l * 512, (const bf16*)(ws + WS_WS) + (size_t)l * 8 * 128 * 128, A->b_s + l * 8 * 128, MIXb, (char*)lds);
            } else if (s == 2 || s == 5) {
                pg8::Gemm g = (s == 2) ? pg8::Gemm{MIXb, (const bf16*)(ws + WS_WOUT) + (size_t)l * DM * DM, M, DM, DM}
                                       : pg8::Gemm{HIDb, (const bf16*)(ws + WS_WF2) + (size_t)l * DM * FFH, M, DM, FFH};
                RowOrder S; S.init(DM, G, bx, (l == DEPTH - 1) || (s == 5 && G == 256));
                pg8::EpiBf16<0> E{Yb, DM, nullptr, 0, 0, 1.f};
                pg8::gemm_phase<pg8::EpiBf16<0>, RowOrder, true, true>((LAS unsigned char*)lds, g, S, E);
                if (s == 2 && G == 256 && l + 1 < DEPTH && bx >= 32)
                    convert_weights(A, lds, (bx - 32) * NWAVES + wave, (G - 32) * NWAVES, l + 1, l + 2, lane, wave);
            } else if (s == 3) {
                RowPass R{A->x, A->ctx, A->out, xc, Yb, Hb, modp, A->g_post_mix + l * DM, A->g_pre_ffn + l * DM, 0, 1, 1, l, 2, l, 3, l == DEPTH - 1};
                row_pass(R, gw, ngw, lane);
                if ((PROBE_DUP >> 10) & 1) { RowPass R2{A->x, A->ctx, A->out, xc, Yb, Hb, modp, A->g_post_mix + l * DM, A->g_pre_ffn + l * DM, 0, 0, 1, l, 2, l, 3, l == DEPTH - 1}; row_pass(R2, gw, ngw, lane); }
            } else if (s == 4) {
                pg8::Gemm g{Hb, (const bf16*)(ws + WS_WF1) + (size_t)l * FF2 * DM, M, FF2, DM};
                EpiSwiglu E{HIDb};
                if (l == DEPTH - 1 || G != 256) {
                    RowOrder S; S.init(FF2, G, bx, l == DEPTH - 1);
                    pg8::gemm_phase<EpiSwiglu, RowOrder, true, true>((LAS unsigned char*)lds, g, S, E);
                } else {
                    unsigned* cnt = (unsigned*)(ws + WS_BAR) + CW_G3C + 64 * l;
                    G3Order S; S.init(bx, cnt);
                    pg8::gemm_phase<EpiSwiglu, G3Order, true, true>((LAS unsigned char*)lds, g, S, E);
                    if (bx < 32) {
                        pg8::Gemm g2{HIDb, (const bf16*)(ws + WS_WF2) + (size_t)l * DM * FFH, M, DM, FFH};
                        CtxOneOrder S2{bx, cnt, 176u * 8u};
                        pg8::EpiBf16<0> E2{Yb, DM, nullptr, 0, 0, 1.f};
                        pg8::gemm_phase<pg8::EpiBf16<0>, CtxOneOrder, true, true>((LAS unsigned char*)lds, g2, S2, E2);
                    }
                }
            } else {
                const int last = (l == DEPTH - 1);
                RowPass R{A->x, A->ctx, A->out, xc, Yb, Hb, modp, A->g_post_ffn + l * DM, A->g_pre_mix + (last ? l : l + 1) * DM, 0, 1, last ? 0 : 1, l, 5, last ? l : l + 1, 0, last};
                row_pass(R, gw, ngw, lane);
            }
        }
        if (st + 1 < A_.ph_hi * 2) { if (A_.ph_hi < 0) grid.sync(); else { XcdBarrier bar; bar.bar = (unsigned*)(A->ws + WS_BAR); bar.x = xb_xcc_id(); bar.st = (volatile LAS unsigned*)((LAS unsigned char*)lds + LDS_STAGE); xcd_barrier(bar); } }
    }
}

#ifndef N_LAUNCH_MODE
#define N_LAUNCH_MODE 1
#endif
extern "C" void kernel_launch(void* const* d_in, const int* in_sizes, int n_in, void* d_out, int out_size, void* d_ws, size_t ws_size, hipStream_t stream) {
    static int grid = 0;
    if (grid == 0) {
        if (n_in != 20 || ws_size < WS_TOTAL) { fprintf(stderr, "kernel_launch: n_in %d ws %zu (need %zu)\n", n_in, ws_size, (size_t)WS_TOTAL); grid = -1; return; }
        int dev = 0, cus = 0, per_cu = 0;
        hipGetDevice(&dev); hipDeviceGetAttribute(&cus, hipDeviceAttributeMultiprocessorCount, dev);
        if (hipFuncSetAttribute((const void*)fwd_kernel, hipFuncAttributeMaxDynamicSharedMemorySize, LDS_BYTES) != hipSuccess) { fprintf(stderr, "kernel_launch: hipFuncSetAttribute failed\n"); grid = -1; return; }
        if (hipOccupancyMaxActiveBlocksPerMultiprocessor(&per_cu, (const void*)fwd_kernel, NTHR, LDS_BYTES) != hipSuccess || per_cu < 1) { fprintf(stderr, "kernel_launch: occupancy query gave %d\n", per_cu); per_cu = 1; }
        (void)hipGetLastError();
        grid = cus;
    }
    if (grid < 0) return;
    if (hipMemsetAsync((char*)d_ws + WS_BAR, 0, BAR_BYTES, stream) != hipSuccess) { fprintf(stderr, "kernel_launch: memset failed\n"); return; }
    Args a{};
    const float** ap = (const float**)&a;
    for (int i = 0; i < 20; ++i) ap[i] = (const float*)d_in[i];
    a.out = (float*)d_out; a.ws = (unsigned char*)d_ws;
#if N_LAUNCH_MODE == 1
    a.ph_lo = 0; a.ph_hi = N_PHASES;
    void* args[] = {&a};
    hipError_t e = hipLaunchCooperativeKernel((const void*)fwd_kernel, dim3(grid), dim3(NTHR), args, LDS_BYTES, stream);
    if (e != hipSuccess) fprintf(stderr, "cooperative launch failed: %s (grid %d)\n", hipGetErrorString(e), grid);
#else
    for (int p = 0; p < N_PHASES; ++p) { a.ph_lo = p; a.ph_hi = p + 1; hipLaunchKernelGGL(fwd_kernel, dim3(grid), dim3(NTHR), LDS_BYTES, stream, a); }
#endif
}
```

```cpp
#include <hip/hip_runtime.h>
#include <cstdio>
#include <cstdint>
__device__ __forceinline__ int tid_fresh() { int t = threadIdx.x; asm volatile("" : "+v"(t)); return t; }
namespace pg8 {
#define PG8_LAS __attribute__((address_space(3)))
typedef unsigned short bf16_t;
typedef short bf16x8 __attribute__((ext_vector_type(8)));
typedef float f32x4 __attribute__((ext_vector_type(4)));
typedef unsigned u32x4 __attribute__((ext_vector_type(4)));
constexpr int BM = 256, BK = 64, HALF = 128, HTB = HALF * BK * 2  , STAGE_BYTES = 8 * HTB, NXCD = 8, WGM = 8;

__host__ __device__ __forceinline__ int lds_byte(int r, int c) { const int st = (r >> 4) * 2 + (c >> 5), rr = r & 15, cc = c & 31, ob = rr * 64 + cc * 2; return st * 1024 + (ob ^ (((ob >> 9) & 1) << 5)); }
__host__ __device__ __forceinline__ void stage_rc(int b, int& R, int& C) { const int st = b / 1024, sb = b % 1024, swz = sb ^ (((sb >> 9) & 1) << 5); R = (st >> 1) * 16 + swz / 64; C = (st & 1) * 32 + (swz % 64) / 2; }
__host__ __device__ __forceinline__ int perm32(int rho) { const int n = rho >> 4, i = rho & 15; return 8 * (i >> 2) + 4 * n + (i & 3); }

struct Unit { int pm, pn; };
struct Gemm { const bf16_t* A; const bf16_t* Bt; int M, N, K; };

struct StaticOrder {
    int nM, nN, nwg, G, c;
    __host__ __device__ void init(int M, int N, int G_, int c_) { nM = M / BM; nN = N / BM; nwg = nM * nN; G = G_; c = c_; }
    __host__ __device__ bool next(int i, Unit& u) const {
        const long L = (long)i * G + c; if (L >= nwg) return false;
        int wgid = (int)L; { const int q = nwg / NXCD, r = nwg % NXCD, xcd = wgid % NXCD, off = wgid / NXCD; wgid = (xcd < r ? xcd * (q + 1) : r * (q + 1) + (xcd - r) * q) + off; }
        const int nig = WGM * nN, gid = wgid / nig, fm = gid * WGM, gsz = (nM - fm) < WGM ? (nM - fm) : WGM;
        u.pm = fm + ((wgid % nig) % gsz); u.pn = (wgid % nig) / gsz; return true;
    }
    __device__ __forceinline__ void a_ready(const Unit&) const {}
    __device__ __forceinline__ void done(const Unit&) const {}
};

__device__ __forceinline__ unsigned cvt_pk_bf16(float lo, float hi) { unsigned r; asm volatile("v_cvt_pk_bf16_f32 %0, %1, %2" : "=v"(r) : "v"(lo), "v"(hi)); return r; }
typedef float f32x2 __attribute__((ext_vector_type(2)));
__device__ __forceinline__ f32x2 gelu_pk(f32x2 v) {
    const f32x2 av = __builtin_elementwise_abs(v), d = av * 0.2316418882f + 1.0f;
    f32x2 t; t.x = __builtin_amdgcn_rcpf(d.x); t.y = __builtin_amdgcn_rcpf(d.y);
    f32x2 q = t * 0.5307027145f + (-0.7265760135f); q = q * t + 0.7107068705f; q = q * t + (-0.142248368f); q = q * t + 0.127414796f; q = q * t;
    const f32x2 s = (v * v) * (-0.72134752044f);
    f32x2 e; e.x = __builtin_amdgcn_exp2f(s.x); e.y = __builtin_amdgcn_exp2f(s.y);
    const f32x2 m = v * (q * e), r = v - m;
    f32x2 o; o.x = v.x < 0.f ? m.x : r.x; o.y = v.y < 0.f ? m.y : r.y; return o;
}

template <int ACT  > struct EpiBf16 {
    static constexpr bool PERM = true, AFTER_DRAIN = false; static_assert(ACT == 0 || ACT == 1, "EpiBf16: ACT is 0 (none) or 1 (gelu_pk)");
    bf16_t* O; int ldc; const float* bias; int split_cols; size_t split_stride; float scale0;
    __device__ __forceinline__ void operator()(const f32x4 (&acc)[2][2][4][2], const Unit& u, int wr, int wc, int fr, int fq) const {
        const int row0 = u.pm * BM + wr * 64 + fr; int colt = u.pn * BM; bf16_t* base = O;
        float sc = 1.f; if (split_cols) { const int t = colt / split_cols; base += (size_t)t * split_stride; colt -= t * split_cols; if (t == 0) sc = scale0; }
        const int col0 = colt + wc * 32 + 8 * fq, bcol0 = u.pn * BM + wc * 32 + 8 * fq;
        f32x4 bv[2][2];
#pragma unroll
        for (int bj = 0; bj < 2; ++bj)
#pragma unroll
            for (int n = 0; n < 2; ++n) bv[bj][n] = bias ? *(const f32x4*)(bias + bcol0 + bj * HALF + 4 * n) : (f32x4){0.f, 0.f, 0.f, 0.f};
#pragma unroll
        for (int ai = 0; ai < 2; ++ai)
#pragma unroll
            for (int m = 0; m < 4; ++m) { bf16_t* rowp = base + (size_t)(row0 + ai * HALF + m * 16) * ldc + col0;
#pragma unroll
                for (int bj = 0; bj < 2; ++bj) { f32x4 v0 = acc[ai][bj][m][0] + bv[bj][0], v1 = acc[ai][bj][m][1] + bv[bj][1];
                    if (ACT == 1) { f32x2 a = gelu_pk((f32x2){v0[0], v0[1]}), b = gelu_pk((f32x2){v0[2], v0[3]}), c = gelu_pk((f32x2){v1[0], v1[1]}), d = gelu_pk((f32x2){v1[2], v1[3]});
                        v0 = (f32x4){a.x, a.y, b.x, b.y}; v1 = (f32x4){c.x, c.y, d.x, d.y}; }
                    v0 = v0 * sc; v1 = v1 * sc; u32x4 w; w.x = cvt_pk_bf16(v0[0], v0[1]); w.y = cvt_pk_bf16(v0[2], v0[3]); w.z = cvt_pk_bf16(v1[0], v1[1]); w.w = cvt_pk_bf16(v1[2], v1[3]);
                    *(u32x4*)(rowp + bj * HALF) = w; } }
    }
};
template <class Epi, class Sched, bool ALIGN_EPI = false, bool SP2 = false>
__device__ __forceinline__ void gemm_phase(PG8_LAS unsigned char* lds, const Gemm g, const Sched& S, const Epi& E) {
    const int tid = tid_fresh(), wid = __builtin_amdgcn_readfirstlane(tid >> 6), lane = tid & 63, wr = wid >> 2, wc = wid & 3, fr = lane & 15, fq = lane >> 4;
    const int K = g.K, nt = K / BK;
    unsigned voffA[2], voffB[2];
#pragma unroll
    for (int i = 0; i < 2; ++i) { int R, C; stage_rc(tid * 16 + i * 8192, R, C); const int Rb = Epi::PERM ? ((R & ~31) + perm32(R & 31)) : R;
        voffA[i] = (unsigned)(R * K + C) * 2u; voffB[i] = (unsigned)(Rb * K + C) * 2u; }
    const size_t kstep = (size_t)(BK * 2);
    const size_t hstep = (size_t)HALF * K * 2;
    const size_t tstep = 2 * hstep;
    const unsigned ldsw = (unsigned)wid * 1024u;
    const int aoff = lds_byte(wr * 64 + fr, fq * 8), boff = lds_byte(wc * 32 + fr, fq * 8);
#define PG8_SA(b, h) (((b) * 2 + (h)) * HTB)
#define PG8_SB(b, h) ((4 + (b) * 2 + (h)) * HTB)
#define PG8_STAGE(bufoff, gbase, voff) do { _Pragma("unroll") for (int _i = 0; _i < 2; ++_i) \
        __builtin_amdgcn_global_load_lds((const unsigned*)((const char*)(gbase) + (voff)[_i]), (PG8_LAS unsigned*)(lds + (bufoff) + ldsw + _i * 8192), 16, 0, 0); } while (0)
#define PG8_LDA(dst, b, h) do { _Pragma("unroll") for (int m = 0; m < 4; ++m) _Pragma("unroll") for (int k = 0; k < 2; ++k) dst[m][k] = *(const PG8_LAS bf16x8*)(lds + PG8_SA(b, h) + aoff + m * 2048 + k * 1024); } while (0)
#define PG8_LDB(dst, b, h) do { _Pragma("unroll") for (int n = 0; n < 2; ++n) _Pragma("unroll") for (int k = 0; k < 2; ++k) dst[n][k] = *(const PG8_LAS bf16x8*)(lds + PG8_SB(b, h) + boff + n * 2048 + k * 1024); } while (0)
#define PG8_MMA(ai, bj, At, Bt) do { __builtin_amdgcn_s_setprio(1); _Pragma("unroll") for (int m = 0; m < 4; ++m) _Pragma("unroll") for (int n = 0; n < 2; ++n) _Pragma("unroll") for (int k = 0; k < 2; ++k) \
        acc[ai][bj][m][n] = __builtin_amdgcn_mfma_f32_16x16x32_bf16(Bt[n][k], At[m][k], acc[ai][bj][m][n], 0, 0, 0); __builtin_amdgcn_s_setprio(0); } while (0)
#define PG8_WAIT_V(n) asm volatile("s_waitcnt vmcnt(" #n ")" ::: "memory")
#define PG8_WAIT_L(n) asm volatile("s_waitcnt lgkmcnt(" #n ")" ::: "memory")
#define PG8_BAR __builtin_amdgcn_s_barrier()
#define PG8_SCHED __builtin_amdgcn_sched_barrier(0)
    Unit cur, nxt; int ui = 0;
    if (!S.next(0, cur)) return;
    f32x4 acc[2][2][4][2];
#pragma unroll
    for (int a = 0; a < 2; ++a)
#pragma unroll
        for (int b = 0; b < 2; ++b)
#pragma unroll
            for (int m = 0; m < 4; ++m)
#pragma unroll
                for (int n = 0; n < 2; ++n) acc[a][b][m][n] = (f32x4){0.f, 0.f, 0.f, 0.f};
    bf16x8 At[4][2], B0[2][2], B1[2][2];
    const char* cA = (const char*)g.A + (size_t)cur.pm * tstep; const char* cB = (const char*)g.Bt + (size_t)cur.pn * tstep;
    S.a_ready(cur);
    if constexpr (SP2) {
        PG8_STAGE(PG8_SB(0, 0), cB, voffB); PG8_STAGE(PG8_SB(0, 1), cB + hstep, voffB); PG8_STAGE(PG8_SA(0, 0), cA, voffA); PG8_STAGE(PG8_SA(0, 1), cA + hstep, voffA);
        if (wr == 1) PG8_BAR;
        PG8_WAIT_V(2); PG8_BAR;
        PG8_STAGE(PG8_SB(1, 0), cB + kstep, voffB); PG8_STAGE(PG8_SA(1, 0), cA + kstep, voffA); PG8_STAGE(PG8_SB(1, 1), cB + hstep + kstep, voffB);
        PG8_WAIT_V(6); PG8_BAR;
    } else {
        PG8_STAGE(PG8_SB(0, 0), cB, voffB); PG8_STAGE(PG8_SA(0, 0), cA, voffA); PG8_STAGE(PG8_SB(0, 1), cB + hstep, voffB); PG8_STAGE(PG8_SA(0, 1), cA + hstep, voffA);
        if (wr == 1) PG8_BAR;
        PG8_WAIT_V(4); PG8_BAR;
        PG8_STAGE(PG8_SB(1, 0), cB + kstep, voffB); PG8_STAGE(PG8_SA(1, 0), cA + kstep, voffA); PG8_STAGE(PG8_SB(1, 1), cB + hstep + kstep, voffB);
        PG8_WAIT_V(6); PG8_BAR;
    }
    for (;;) {
        const bool has_next = S.next(ui + 1, nxt);
        const char* nA = has_next ? (const char*)g.A + (size_t)nxt.pm * tstep : cA; const char* nB = has_next ? (const char*)g.Bt + (size_t)nxt.pn * tstep : cB;
        for (int t = 0; t < nt; t += 2) {
            const bool last = (t == nt - 2);
            const char* a1 = cA + (size_t)(t + 1) * kstep;
            const char* a2 = last ? nA : cA + (size_t)(t + 2) * kstep; const char* b2 = last ? nB : cB + (size_t)(t + 2) * kstep;
            const char* a3 = a2 + kstep; const char* b3 = b2 + kstep;
            if (last && has_next) S.a_ready(nxt);
            if constexpr (SP2) {
            PG8_LDB(B0, 0, 0); PG8_LDB(B1, 0, 1); PG8_SCHED; PG8_LDA(At, 0, 0); PG8_STAGE(PG8_SA(1, 1), a1 + hstep, voffA);
            PG8_WAIT_V(8); PG8_WAIT_L(0); PG8_BAR; PG8_MMA(0, 0, At, B0); PG8_MMA(0, 1, At, B1); PG8_BAR; PG8_SCHED;
            PG8_LDA(At, 0, 1); PG8_STAGE(PG8_SB(0, 0), b2, voffB); PG8_STAGE(PG8_SB(0, 1), b2 + hstep, voffB); PG8_STAGE(PG8_SA(0, 0), a2, voffA);
            PG8_WAIT_V(8); PG8_WAIT_L(0); PG8_BAR; PG8_MMA(1, 0, At, B0); PG8_MMA(1, 1, At, B1); PG8_BAR; PG8_SCHED;
            PG8_LDB(B0, 1, 0); PG8_LDB(B1, 1, 1); PG8_SCHED; PG8_LDA(At, 1, 0); PG8_STAGE(PG8_SA(0, 1), a2 + hstep, voffA);
            PG8_WAIT_V(8); PG8_WAIT_L(0); PG8_BAR; PG8_MMA(0, 0, At, B0); PG8_MMA(0, 1, At, B1); PG8_BAR; PG8_SCHED;
            PG8_LDA(At, 1, 1); PG8_STAGE(PG8_SB(1, 0), b3, voffB); PG8_STAGE(PG8_SB(1, 1), b3 + hstep, voffB); PG8_STAGE(PG8_SA(1, 0), a3, voffA);
            PG8_WAIT_V(8); PG8_WAIT_L(0); PG8_BAR; PG8_MMA(1, 0, At, B0); PG8_MMA(1, 1, At, B1); PG8_BAR; PG8_SCHED;
            } else {
            PG8_LDB(B0, 0, 0); PG8_SCHED; PG8_LDA(At, 0, 0); PG8_STAGE(PG8_SA(1, 1), a1 + hstep, voffA);
            PG8_WAIT_L(8); PG8_BAR; PG8_WAIT_L(0); PG8_MMA(0, 0, At, B0); PG8_BAR; PG8_SCHED;
            PG8_LDB(B1, 0, 1); PG8_STAGE(PG8_SB(0, 0), b2, voffB);
            PG8_BAR; PG8_WAIT_L(0); PG8_MMA(0, 1, At, B1); PG8_BAR;
            PG8_LDA(At, 0, 1); PG8_STAGE(PG8_SA(0, 0), a2, voffA);
            PG8_BAR; PG8_WAIT_L(0); PG8_MMA(1, 0, At, B0); PG8_BAR; PG8_SCHED;
            PG8_STAGE(PG8_SB(0, 1), b2 + hstep, voffB);
            PG8_WAIT_V(6); PG8_BAR; PG8_MMA(1, 1, At, B1); PG8_BAR;
            PG8_LDB(B0, 1, 0); PG8_SCHED; PG8_LDA(At, 1, 0); PG8_STAGE(PG8_SA(0, 1), a2 + hstep, voffA);
            PG8_WAIT_L(8); PG8_BAR; PG8_WAIT_L(0); PG8_MMA(0, 0, At, B0); PG8_BAR; PG8_SCHED;
            PG8_LDB(B1, 1, 1); PG8_STAGE(PG8_SB(1, 0), b3, voffB);
            PG8_BAR; PG8_WAIT_L(0); PG8_MMA(0, 1, At, B1); PG8_BAR;
            PG8_LDA(At, 1, 1); PG8_STAGE(PG8_SA(1, 0), a3, voffA);
            PG8_BAR; PG8_WAIT_L(0); PG8_MMA(1, 0, At, B0); PG8_BAR; PG8_SCHED;
            PG8_STAGE(PG8_SB(1, 1), b3 + hstep, voffB);
            PG8_WAIT_V(6); PG8_BAR; PG8_MMA(1, 1, At, B1); PG8_BAR;
            }
        }
        if constexpr (ALIGN_EPI) { if (wr == 0) PG8_BAR; }
        if constexpr (!Epi::AFTER_DRAIN) { E(acc, cur, wr, wc, fr, fq); S.done(cur); }
        if (!has_next) break;
#pragma unroll
        for (int a = 0; a < 2; ++a)
#pragma unroll
            for (int b = 0; b < 2; ++b)
#pragma unroll
                for (int m = 0; m < 4; ++m)
#pragma unroll
                    for (int n = 0; n < 2; ++n) acc[a][b][m][n] = (f32x4){0.f, 0.f, 0.f, 0.f};
        cur = nxt; cA = nA; cB = nB; ++ui;
        if constexpr (ALIGN_EPI) { if (wr == 1) PG8_BAR; }
    }
    PG8_WAIT_V(0);
    if constexpr (!ALIGN_EPI) { if (wr == 0) PG8_BAR; }
    PG8_BAR;
    if constexpr (Epi::AFTER_DRAIN) { E.fused(acc, cur, wr, wc, fr, fq, lds, wid, lane); S.done(cur); }
#undef PG8_SA
#undef PG8_SB
#undef PG8_STAGE
#undef PG8_LDA
#undef PG8_LDB
#undef PG8_MMA
#undef PG8_WAIT_V
#undef PG8_WAIT_L
#undef PG8_BAR
#undef PG8_SCHED
}
}

#include <hip/hip_cooperative_groups.h>
namespace cg = cooperative_groups;

#define LAS __attribute__((address_space(3)))
typedef unsigned short bf16;
typedef float f32x4 __attribute__((ext_vector_type(4)));
typedef float f32x16 __attribute__((ext_vector_type(16)));
typedef short bf16x8 __attribute__((ext_vector_type(8)));
typedef short s16x4 __attribute__((ext_vector_type(4)));
typedef unsigned u32x4 __attribute__((ext_vector_type(4)));
typedef unsigned u32x2 __attribute__((ext_vector_type(2)));

constexpr int DM = 1024, NB = 8, SEQ = 4096, CTXL = 256, DEPTH = 4;
constexpr int RPB = SEQ + CTXL;
constexpr int M = NB * RPB;
constexpr int INW = 1792, FFH = 2816, FF2 = 2 * FFH;
constexpr int NMOD = 6;
constexpr float EPS = 1e-6f;
constexpr int NWAVES = 8, NTHR = 512;
constexpr int LDS_STAGE = 131072, LDS_BYTES = LDS_STAGE + 256;

constexpr size_t al256(size_t x) { return (x + 255) / 256 * 256; }
constexpr size_t WS_WIN = 0;
constexpr size_t WS_WOUT = WS_WIN + al256((size_t)DEPTH * INW * DM * 2);
constexpr size_t WS_WF1 = WS_WOUT + al256((size_t)DEPTH * DM * DM * 2);
constexpr size_t WS_WF2 = WS_WF1 + al256((size_t)DEPTH * FF2 * DM * 2);
constexpr size_t WS_WS = WS_WF2 + al256((size_t)DEPTH * DM * FFH * 2);
constexpr size_t WS_MOD = WS_WS + al256((size_t)DEPTH * 8 * 128 * 128 * 2);
constexpr size_t WS_ROPE = WS_MOD + al256((size_t)DEPTH * 9 * NMOD * DM * 4);
constexpr size_t WS_STATS = WS_ROPE + al256(2 * 64 * 16 * 4);
constexpr size_t WS_XC = WS_STATS + al256((size_t)M * 16 * 4);
constexpr size_t WS_H = WS_XC + al256((size_t)NB * CTXL * DM * 4);
constexpr size_t WS_Y = WS_H + al256((size_t)M * DM * 2);
constexpr size_t WS_BIG = WS_Y + al256((size_t)M * DM * 2);
constexpr size_t WS_Q = WS_BIG;
constexpr size_t WS_K = WS_Q + (size_t)M * 512 * 2;
constexpr size_t WS_V = WS_K + (size_t)M * 128 * 2;
constexpr size_t WS_U = WS_V + (size_t)M * 128 * 2;
constexpr size_t WS_VG = WS_U + (size_t)M * 512 * 2;
constexpr size_t WS_MIX = WS_VG + (size_t)M * 512 * 2;
constexpr size_t WS_END = WS_BIG + al256((size_t)M * FFH * 2);
constexpr size_t WS_BAR = WS_END, BAR_BYTES = 16384, WS_TOTAL = WS_BAR + BAR_BYTES;
static_assert(WS_MIX + (size_t)M * DM * 2 <= WS_END, "overlay");

struct Args {
    const float *x, *c, *ctx, *c_ctx, *w_mod, *b_mod, *g_pre_mix, *g_post_mix, *g_pre_ffn, *g_post_ffn, *w_in, *g_q, *g_k, *g_sg, *b_sg, *w_s, *b_s, *w_out, *w_ffn_in, *w_ffn_out;
    float* out; unsigned char* ws; int ph_lo, ph_hi;
};

typedef const __attribute__((address_space(4))) Args* ArgP;

#define XB_TMO      128
#define XB_XCNT(j)  (256  + 64 * (j))
#define XB_XSUB(j)  (1280 + 64 * (j))
#define XB_XGEN(j)  (2304 + 64 * (j))
#define XB_TOP      3328
#define XB_TOPGEN   3392
#define XCD_BAR_WORDS 3456
#define XB_SPIN_CAP (1u << 18)

__device__ __forceinline__ unsigned xb_ld(unsigned* p)              { return __hip_atomic_load(p, __ATOMIC_RELAXED, __HIP_MEMORY_SCOPE_AGENT); }
__device__ __forceinline__ unsigned xb_add(unsigned* p, unsigned v) { return __hip_atomic_fetch_add(p, v, __ATOMIC_RELAXED, __HIP_MEMORY_SCOPE_AGENT); }
__device__ __forceinline__ unsigned xb_xcc_id() { return (unsigned)__builtin_amdgcn_s_getreg((3 << 11) | 20) & 0xFu; }
#define XB_SPIN(cond, bar) do { unsigned _sp = 0; while (cond) { __builtin_amdgcn_s_sleep(1); \
    if ((++_sp & 255u) == 0u) { if (xb_ld(&(bar)[XB_TMO])) break; if (_sp > XB_SPIN_CAP) { atomicAdd(&(bar)[XB_TMO], 1u); break; } } } } while (0)

struct XcdBarrier {
    unsigned* bar; unsigned x;
    volatile LAS unsigned* st;
};

__device__ __forceinline__ XcdBarrier xcd_barrier_post(unsigned* bar, volatile LAS unsigned* st) {
    XcdBarrier b; b.bar = bar; b.x = xb_xcc_id(); b.st = st;
    if (threadIdx.x == 0) (void)xb_add(&bar[XB_XCNT(b.x)], 1u);
    return b;
}
__device__ __forceinline__ void xcd_barrier_complete(unsigned* bar, unsigned x, unsigned& nloc, unsigned& nx) {
    const unsigned G = gridDim.x * gridDim.y * gridDim.z;
    unsigned sum, cnt, mine, sp = 0u;
    for (;;) {
        sum = 0u; cnt = 0u; mine = 0u;
#pragma unroll
        for (unsigned j = 0; j < 16; ++j) { const unsigned c = xb_ld(&bar[XB_XCNT(j)]); sum += c; cnt += (c > 0u) ? 1u : 0u; mine = (j == x) ? c : mine; }
        if (sum == G) break;
        __builtin_amdgcn_s_sleep(1);
        if ((++sp & 255u) == 0u) { if (xb_ld(&bar[XB_TMO])) break; if (sp > XB_SPIN_CAP) { atomicAdd(&bar[XB_TMO], 1u); break; } }
    }
    nloc = mine > 0u ? mine : 1u; nx = cnt > 0u ? cnt : 1u;
}

__device__ __forceinline__ void xcd_barrier(const XcdBarrier& b) {
    asm volatile("s_waitcnt vmcnt(0)" ::: "memory");
    __syncthreads();
    if (threadIdx.x == 0) {
        unsigned* bar = b.bar;
        __builtin_amdgcn_s_waitcnt(0);
        unsigned nloc = b.st[0], nx = b.st[1];
        if (nloc == 0u) { xcd_barrier_complete(bar, b.x, nloc, nx); b.st[0] = nloc; b.st[1] = nx; }
        const unsigned old = xb_add(&bar[XB_XSUB(b.x)], 1u);
        const unsigned gen = old / nloc;
        if (old + 1u == (gen + 1u) * nloc) {
            __builtin_amdgcn_fence(__ATOMIC_RELEASE, "agent");
            asm volatile("s_waitcnt vmcnt(0)" ::: "memory");
            const unsigned og = xb_add(&bar[XB_TOP], 1u);
            const unsigned tg = og / nx;
            if (og + 1u == (tg + 1u) * nx) xb_add(&bar[XB_TOPGEN], 1u);
            else XB_SPIN(xb_ld(&bar[XB_TOPGEN]) == tg, bar);
            __builtin_amdgcn_fence(__ATOMIC_ACQUIRE, "agent");
            xb_add(&bar[XB_XGEN(b.x)], 1u);
            asm volatile("s_waitcnt vmcnt(0)" ::: "memory");
        } else {
            XB_SPIN(xb_ld(&bar[XB_XGEN(b.x)]) == gen, bar);
            __builtin_amdgcn_fence(__ATOMIC_ACQUIRE, "agent");
            asm volatile("s_waitcnt vmcnt(0)" ::: "memory");
        }
    }
    __syncthreads();
}


__device__ __forceinline__ unsigned f2bf(float f) { unsigned u = __builtin_bit_cast(unsigned, f); return (u + 0x7fffu + ((u >> 16) & 1u)) >> 16; }
__device__ __forceinline__ unsigned pk2(float lo, float hi) { return pg8::cvt_pk_bf16(lo, hi); }
__device__ __forceinline__ float bflo(unsigned w) { return __uint_as_float(w << 16); }
__device__ __forceinline__ float bfhi(unsigned w) { return __uint_as_float(w & 0xffff0000u); }
__device__ __forceinline__ float wave_sum(float v) {
#pragma unroll
    for (int o = 1; o < 64; o <<= 1) v += __shfl_xor(v, o);
    return v;
}
__device__ __forceinline__ float gelu_tanh(float x) {
    const float u = x * (0.7978845608028654f + 0.035677408136300125f * x * x);
    return x * __builtin_amdgcn_rcpf(1.0f + __builtin_amdgcn_exp2f(-2.8853900817779268f * u));
}
__device__ __forceinline__ float silu_f(float x) { return x * __builtin_amdgcn_rcpf(1.0f + __builtin_amdgcn_exp2f(-1.4426950408889634f * x)); }

struct EpiInProj {
    static constexpr bool PERM = true, AFTER_DRAIN = false;
    unsigned char* wsb; const float *gq, *gk;
    __device__ __forceinline__ void operator()(const f32x4 (&acc)[2][2][4][2], const pg8::Unit& u, int wr, int wc, int fr, int fq) const {
        const int pm = u.pm, pn = u.pn;
        bf16* const Q = (bf16*)(wsb + WS_Q); bf16* const K = (bf16*)(wsb + WS_K); bf16* const V = (bf16*)(wsb + WS_V); bf16* const U = (bf16*)(wsb + WS_U); bf16* const VG = (bf16*)(wsb + WS_VG);
        float* const stats = (float*)(wsb + WS_STATS); const float* const ropec = (const float*)(wsb + WS_ROPE); const float* const ropes = ropec + 1024;
        const bool isctx = (pm % 17) == 0;
        const int seq0 = ((pm % 17) - 1) * 256;
        if (pn <= 2 && !(pn == 2 && wc >= 2)) {
            const bool isq = pn < 2;
            const float qscale = isq ? 0.125f * 1.4426950408889634f : 1.0f;
            const float* g = isq ? gq : gk;
            bf16* dst; int pitch, hcol;
            if (isq) { dst = Q; pitch = 512; hcol = (pn * 4 + wc) * 64; } else { dst = K; pitch = 128; hcol = wc * 64; }
            f32x4 gv[2][2];
#pragma unroll
            for (int bj = 0; bj < 2; ++bj)
#pragma unroll
                for (int n = 0; n < 2; ++n) gv[bj][n] = *(const f32x4*)(g + 32 * bj + 8 * fq + 4 * n);
            const int fbase = 8 * (fq & 1);
            const bool lowhalf = fq < 2;
#pragma unroll
            for (int ai = 0; ai < 2; ++ai)
#pragma unroll
                for (int m = 0; m < 4; ++m) {
                    const int rl = ai * 128 + wr * 64 + m * 16 + fr;
                    const int row = pm * 256 + rl;
                    float ss = 0.f;
#pragma unroll
                    for (int bj = 0; bj < 2; ++bj)
#pragma unroll
                        for (int n = 0; n < 2; ++n) { const f32x4 v = acc[ai][bj][m][n]; ss += (v[0] * v[0] + v[1] * v[1]) + (v[2] * v[2] + v[3] * v[3]); }
                    ss += __shfl_xor(ss, 16); ss += __shfl_xor(ss, 32);
                    const float rstd = __builtin_amdgcn_rsqf(ss * (1.0f / 64.0f) + EPS);
                    const int sp = seq0 + rl;
#pragma unroll
                    for (int bj = 0; bj < 2; ++bj) {
                        f32x4 y0 = acc[ai][bj][m][0] * (rstd * qscale) * gv[bj][0], y1 = acc[ai][bj][m][1] * (rstd * qscale) * gv[bj][1];
                        if (!isctx) {
                            const int pos = bj == 0 ? (sp >> 6) : (sp & 63);
                            const f32x4 c0 = *(const f32x4*)(ropec + pos * 16 + fbase), c1 = *(const f32x4*)(ropec + pos * 16 + fbase + 4);
                            const f32x4 s0 = *(const f32x4*)(ropes + pos * 16 + fbase), s1 = *(const f32x4*)(ropes + pos * 16 + fbase + 4);
                            f32x4 p0, p1;
#pragma unroll
                            for (int j = 0; j < 4; ++j) { p0[j] = __shfl_xor(y0[j], 32); p1[j] = __shfl_xor(y1[j], 32); }
                            if (lowhalf) { y0 = y0 * c0 - p0 * s0; y1 = y1 * c1 - p1 * s1; }
                            else         { y0 = p0 * s0 + y0 * c0; y1 = p1 * s1 + y1 * c1; }
                        }
                        u32x4 w; w.x = pk2(y0[0], y0[1]); w.y = pk2(y0[2], y0[3]); w.z = pk2(y1[0], y1[1]); w.w = pk2(y1[2], y1[3]);
                        *(u32x4*)(dst + (size_t)row * pitch + hcol + 32 * bj + 8 * fq) = w;
                    }
                }
        } else if (pn == 2) {
            const int hcol = (wc - 2) * 64;
#pragma unroll
            for (int ai = 0; ai < 2; ++ai)
#pragma unroll
                for (int m = 0; m < 4; ++m) {
                    const int row = pm * 256 + ai * 128 + wr * 64 + m * 16 + fr;
#pragma unroll
                    for (int bj = 0; bj < 2; ++bj) {
                        const f32x4 y0 = acc[ai][bj][m][0], y1 = acc[ai][bj][m][1];
                        u32x4 w; w.x = pk2(y0[0], y0[1]); w.y = pk2(y0[2], y0[3]); w.z = pk2(y1[0], y1[1]); w.w = pk2(y1[2], y1[3]);
                        *(u32x4*)(V + (size_t)row * 128 + hcol + 32 * bj + 8 * fq) = w;
                    }
                }
        } else {
            const bool isv = pn >= 5;
            bf16* dst = isv ? VG : U;
            const int cb = ((pn - (isv ? 5 : 3)) * 4 + wc) * 64;
#pragma unroll
            for (int ai = 0; ai < 2; ++ai)
#pragma unroll
                for (int m = 0; m < 4; ++m) {
                    const int row = pm * 256 + ai * 128 + wr * 64 + m * 16 + fr;
                    float s1 = 0.f, s2 = 0.f;
#pragma unroll
                    for (int bj = 0; bj < 2; ++bj) {
                        f32x4 y0 = acc[ai][bj][m][0], y1 = acc[ai][bj][m][1];
#pragma unroll
                        for (int j = 0; j < 4; ++j) { y0[j] = gelu_tanh(y0[j]); y1[j] = gelu_tanh(y1[j]); }
                        s1 += (y0[0] + y0[1]) + (y0[2] + y0[3]) + (y1[0] + y1[1]) + (y1[2] + y1[3]);
                        s2 += (y0[0] * y0[0] + y0[1] * y0[1]) + (y0[2] * y0[2] + y0[3] * y0[3]) + (y1[0] * y1[0] + y1[1] * y1[1]) + (y1[2] * y1[2] + y1[3] * y1[3]);
                        u32x4 w; w.x = pk2(y0[0], y0[1]); w.y = pk2(y0[2], y0[3]); w.z = pk2(y1[0], y1[1]); w.w = pk2(y1[2], y1[3]);
                        *(u32x4*)(dst + (size_t)row * 512 + cb + 32 * bj + 8 * fq) = w;
                    }
                    if (isv) {
                        s1 += __shfl_xor(s1, 16); s1 += __shfl_xor(s1, 32); s2 += __shfl_xor(s2, 16); s2 += __shfl_xor(s2, 32);
                        if (fq == 0) { float* sp = stats + (size_t)row * 16 + ((pn - 5) * 4 + wc) * 2; sp[0] = s1; sp[1] = s2; }
                    }
                }
        }
    }
};
struct EpiSwiglu {
    static constexpr bool PERM = true, AFTER_DRAIN = false;
    bf16* HID;
    __device__ __forceinline__ void operator()(const f32x4 (&acc)[2][2][4][2], const pg8::Unit& u, int wr, int wc, int fr, int fq) const {
#pragma unroll
        for (int ai = 0; ai < 2; ++ai)
#pragma unroll
            for (int m = 0; m < 4; ++m) {
                const int row = u.pm * 256 + ai * 128 + wr * 64 + m * 16 + fr;
                const f32x4 g0 = acc[ai][0][m][0], g1 = acc[ai][0][m][1], u0 = acc[ai][1][m][0], u1 = acc[ai][1][m][1];
                f32x4 y0, y1;
#pragma unroll
                for (int j = 0; j < 4; ++j) { y0[j] = silu_f(g0[j]) * u0[j]; y1[j] = silu_f(g1[j]) * u1[j]; }
                u32x4 w; w.x = pk2(y0[0], y0[1]); w.y = pk2(y0[2], y0[3]); w.z = pk2(y1[0], y1[1]); w.w = pk2(y1[2], y1[3]);
                *(u32x4*)(HID + (size_t)row * FFH + u.pn * 128 + wc * 32 + 8 * fq) = w;
            }
    }
};

struct RowOrder {
    pg8::StaticOrder b; int lat;
    __device__ __forceinline__ void init(int N, int G, int c, int latent_only) { lat = latent_only; b.init(latent_only ? NB * SEQ : M, N, G, c); }
    __device__ __forceinline__ bool next(int i, pg8::Unit& u) const { if (!b.next(i, u)) return false; if (lat) u.pm = u.pm + (u.pm >> 4) + 1; return true; }
    __device__ __forceinline__ void a_ready(const pg8::Unit&) const {}
    __device__ __forceinline__ void done(const pg8::Unit&) const {}
};

constexpr int CW_G3C = 3520;
struct G3Order {
    pg8::StaticOrder lat; int c; unsigned* cnt;
    __device__ __forceinline__ void init(int c_, unsigned* cnt_) { lat.init(NB * SEQ, FF2, 1, 0); c = c_; cnt = cnt_; }
    __device__ __forceinline__ bool next(int i, pg8::Unit& u) const {
        int idx;
        if (i < 10) idx = i * 256 + c;
        else { if (c < 32) return false; idx = 2560 + (c - 32) + (i - 10) * 224; if (idx >= 2992) return false; }
        if (idx < 176) { u.pm = 17 * (idx / 22); u.pn = idx % 22; }
        else { lat.next(idx - 176, u); u.pm = u.pm + (u.pm >> 4) + 1; }
        return true;
    }
    __device__ __forceinline__ void a_ready(const pg8::Unit&) const {}
    __device__ __forceinline__ void done(const pg8::Unit& u) const {
        if ((u.pm % 17) == 0) {
            __builtin_amdgcn_fence(__ATOMIC_RELEASE, "agent");
            asm volatile("s_waitcnt vmcnt(0)" ::: "memory");
            if ((threadIdx.x & 63) == 0) __hip_atomic_fetch_add(cnt, 1u, __ATOMIC_RELAXED, __HIP_MEMORY_SCOPE_AGENT);
        }
    }
};
struct CtxOneOrder {
    int c; unsigned* cnt; unsigned need;
    __device__ __forceinline__ bool next(int i, pg8::Unit& u) const { if (i != 0) return false; u.pm = 17 * (c >> 2); u.pn = c & 3; return true; }
    __device__ __forceinline__ void a_ready(const pg8::Unit&) const {
        unsigned sp = 0;
        while ((unsigned)__builtin_amdgcn_readfirstlane(__hip_atomic_load(cnt, __ATOMIC_RELAXED, __HIP_MEMORY_SCOPE_AGENT)) < need) { __builtin_amdgcn_s_sleep(4); if (++sp > (1u << 22)) break; }
        __builtin_amdgcn_fence(__ATOMIC_ACQUIRE, "agent");
        asm volatile("s_waitcnt vmcnt(0)" ::: "memory");
    }
    __device__ __forceinline__ void done(const pg8::Unit&) const {}
};

namespace att {
constexpr int D = 64, QBLK = 32, KVBLK = 64;
constexpr float SCALE = 0.125f, THR = 8.f;
constexpr int SHM_T = KVBLK * D * 2;
constexpr int NSLOT = 4, OFF_V = 0, OFF_K = NSLOT * SHM_T, OFF_WS = 2 * NSLOT * SHM_T, OFF_OST = OFF_WS + NWAVES * 64 * 4, SHM_ATTN = OFF_OST + NWAVES * 4096;
#define SBAR() __builtin_amdgcn_sched_barrier(0)
#define KSWZ(s, colB) ((s) * 256 + ((colB) ^ (((s) & 7) << 4)))
__device__ __forceinline__ int crow(int r, int hi) { return (r & 3) + 8 * (r >> 2) + 4 * hi; }
__device__ __forceinline__ unsigned cvtpk(float lo, float hi) { unsigned r; asm volatile("v_cvt_pk_bf16_f32 %0, %1, %2" : "=v"(r) : "v"(lo), "v"(hi)); return r; }

__device__ __forceinline__ void partialSM(f32x16& p0) {
#pragma unroll
    for (int r = 0; r < 16; ++r) p0[r] = __builtin_amdgcn_exp2f(p0[r]);
}
__device__ __forceinline__ void finishSM(f32x16& p0, f32x16& p1, float& l_reg, bf16x8& pa0, bf16x8& pa1, bf16x8& pa2, bf16x8& pa3) {
#pragma unroll
    for (int r = 0; r < 16; ++r) p1[r] = __builtin_amdgcn_exp2f(p1[r]);
    float ps = p0[0];
#pragma unroll
    for (int r = 1; r < 16; ++r) ps += p0[r];
#pragma unroll
    for (int r = 0; r < 16; ++r) ps += p1[r];
    l_reg += ps;
#define PK4(P, BASE, OUT) do { unsigned a0 = cvtpk(P[BASE + 0], P[BASE + 1]), a1 = cvtpk(P[BASE + 2], P[BASE + 3]);   \
    unsigned b0 = cvtpk(P[BASE + 4], P[BASE + 5]), b1 = cvtpk(P[BASE + 6], P[BASE + 7]);                              \
    u32x4 w = {a0, a1, b0, b1}; OUT = *reinterpret_cast<bf16x8*>(&w); } while (0)
    PK4(p0, 0, pa0); PK4(p0, 8, pa1); PK4(p1, 0, pa2); PK4(p1, 8, pa3);
#undef PK4
}
__device__ __forceinline__ void qkt(f32x16& p0, f32x16& p1, const char* Ks, const bf16x8* qr, const f32x16& negm, int r32, int hi) {
#pragma unroll
    for (int d0 = 0; d0 < 4; ++d0) { const int cb = (d0 * 16 + hi * 8) * 2;
        const bf16x8 b0 = *reinterpret_cast<const bf16x8*>(Ks + KSWZ(r32, cb));
        const bf16x8 b1 = *reinterpret_cast<const bf16x8*>(Ks + KSWZ(r32, 128 + cb));
        if (d0 == 0) { p0 = __builtin_amdgcn_mfma_f32_32x32x16_bf16(b0, qr[0], negm, 0, 0, 0); p1 = __builtin_amdgcn_mfma_f32_32x32x16_bf16(b1, qr[0], negm, 0, 0, 0); }
        else { p0 = __builtin_amdgcn_mfma_f32_32x32x16_bf16(b0, qr[d0], p0, 0, 0, 0); p1 = __builtin_amdgcn_mfma_f32_32x32x16_bf16(b1, qr[d0], p1, 0, 0, 0); } }
}
__device__ __forceinline__ int v_st(int k, int c) { const int kk = (k & ~0xC) | ((k & 4) << 1) | ((k & 8) >> 1); return ((kk >> 3) * 2 + (c >> 5)) * 512 + ((kk & 7) * 32 + (c & 31)) * 2; }
__device__ __forceinline__ int v_rd_base(int lane) { return (((lane & 3) << 3) | (((lane >> 2) & 3) << 6) | (((lane >> 4) & 1) << 5)) + ((lane >> 5) & 1) * 1024; }
constexpr int v_rd_off(int d0, int ks, int half) { return d0 * 512 + ks * 2048 + half * 256; }
typedef short v4i16_t __attribute__((ext_vector_type(4)));
template <int OFF> __device__ __forceinline__ s16x4 tr_read(int vb) {
    return __builtin_bit_cast(s16x4, __builtin_amdgcn_ds_read_tr16_b64_v4i16((LAS v4i16_t*)(unsigned)(vb + OFF)));
}
template <int D0> __device__ __forceinline__ void pv_one(f32x16& od, int vb, bf16x8 pa0, bf16x8 pa1, bf16x8 pa2, bf16x8 pa3) {
    const s16x4 l0 = tr_read<v_rd_off(D0, 0, 0)>(vb), h0 = tr_read<v_rd_off(D0, 0, 1)>(vb), l1 = tr_read<v_rd_off(D0, 1, 0)>(vb), h1 = tr_read<v_rd_off(D0, 1, 1)>(vb);
    const s16x4 l2 = tr_read<v_rd_off(D0, 2, 0)>(vb), h2 = tr_read<v_rd_off(D0, 2, 1)>(vb), l3 = tr_read<v_rd_off(D0, 3, 0)>(vb), h3 = tr_read<v_rd_off(D0, 3, 1)>(vb);
#define PK(L, H) (bf16x8){L[0], L[1], L[2], L[3], H[0], H[1], H[2], H[3]}
    od = __builtin_amdgcn_mfma_f32_32x32x16_bf16(pa0, PK(l0, h0), od, 0, 0, 0);
    od = __builtin_amdgcn_mfma_f32_32x32x16_bf16(pa1, PK(l1, h1), od, 0, 0, 0);
    od = __builtin_amdgcn_mfma_f32_32x32x16_bf16(pa2, PK(l2, h2), od, 0, 0, 0);
    od = __builtin_amdgcn_mfma_f32_32x32x16_bf16(pa3, PK(l3, h3), od, 0, 0, 0);
#undef PK
}
__device__ __forceinline__ void pv_d0(f32x16* o, int vb, bf16x8 pa0, bf16x8 pa1, bf16x8 pa2, bf16x8 pa3) {
    pv_one<0>(o[0], vb, pa0, pa1, pa2, pa3); pv_one<1>(o[1], vb, pa0, pa1, pa2, pa3);
}
constexpr int LDQ = 512, LDK = 128, LDO = 1024;
__device__ __forceinline__ void attn_body(const bf16* __restrict__ Qb, const bf16* __restrict__ Kh, const bf16* __restrict__ Vh, bf16* __restrict__ Ob, int seq, float m0l2, char* lds, bool pre, bool post) {
    const int tid = tid_fresh(), wid = tid >> 6, lane = tid & 63, r32 = lane & 31, hi = lane >> 5;
    char* V_lds = lds + OFF_V; char* K_lds = lds + OFF_K;
    float* li_l = (float*)(lds + OFF_WS) + wid * 64;
    float l_reg = 0; f32x16 o[2] = {}; bf16x8 qr[4];
    f32x16 negm;
#pragma unroll
    for (int r = 0; r < 16; ++r) negm[r] = -m0l2;
    asm volatile("" : "+v"(negm));
    const bf16* Qw = Qb + (long)(wid * QBLK + r32) * LDQ + hi * 8;
#pragma unroll
    for (int d0 = 0; d0 < 4; ++d0) qr[d0] = __builtin_nontemporal_load(reinterpret_cast<const bf16x8*>(Qw + d0 * 16));
    const int wsg = __builtin_amdgcn_readfirstlane(wid);
    const int oo = (wsg * 64 + lane) * 16;
    const int ksr = oo >> 8, kcolB = (oo & 255) ^ ((ksr & 7) << 4);
    const bf16* kptr = Kh + (long)(ksr + 32 * (kcolB >> 7)) * LDK + ((kcolB & 127) >> 1);
    const int vkk = ((oo >> 9) >> 1) * 8 + ((oo & 511) >> 6), vcc = ((oo >> 9) & 1) * 32 + ((oo & 63) >> 1);
    const bf16* vptr = Vh + (long)((vkk & ~0xC) | ((vkk & 4) << 1) | ((vkk & 8) >> 1)) * LDK + vcc;
    LAS unsigned char* const ldsK = (LAS unsigned char*)lds + OFF_K + wsg * 1024; LAS unsigned char* const ldsV = (LAS unsigned char*)lds + OFF_V + wsg * 1024;
    const int vb0 = (int)(uintptr_t)V_lds + v_rd_base(lane);
    const int NT = seq / KVBLK;
#define SLOT(t) (((t) & 3) << 13)
#define DMA(t) do { const int t_ = (t) < NT ? (t) : NT - 1; const long off_ = (long)t_ * (KVBLK * LDK); \
        __builtin_amdgcn_global_load_lds((const unsigned*)(kptr + off_), (LAS unsigned*)(ldsK + SLOT(t)), 16, 0, 0); \
        __builtin_amdgcn_global_load_lds((const unsigned*)(vptr + off_), (LAS unsigned*)(ldsV + SLOT(t)), 16, 0, 0); } while (0)
#define WBAR(N) asm volatile("s_waitcnt vmcnt(" #N ") lgkmcnt(0)\n\ts_barrier" ::: "memory")
    f32x16 pA0, pA1, pB0, pB1; bf16x8 pa0, pa1, pa2, pa3;
#define HALF(PX0, PX1, PY0, PY1, j_, MORE) do { \
        SBAR(); if (MORE) DMA((j_) + 2); qkt(PX0, PX1, K_lds + SLOT(j_), qr, negm, r32, hi); \
        finishSM(PY0, PY1, l_reg, pa0, pa1, pa2, pa3); \
        pv_d0(o, vb0 + SLOT((j_) - 1), pa0, pa1, pa2, pa3); partialSM(PX0); \
        if (MORE) WBAR(2); else WBAR(0); } while (0)
    if (!pre) { DMA(0); DMA(1); } DMA(2); WBAR(2);
    qkt(pA0, pA1, K_lds, qr, negm, r32, hi); partialSM(pA0);
    int j = 1;
    for (; j + 4 < NT; j += 2) {
        HALF(pB0, pB1, pA0, pA1, j, true);
        HALF(pA0, pA1, pB0, pB1, j + 1, true);
    }
    HALF(pB0, pB1, pA0, pA1, j, true);
    HALF(pA0, pA1, pB0, pB1, j + 1, false);
    if (post) { DMA(0); DMA(1); }
    SBAR(); qkt(pB0, pB1, K_lds + SLOT(NT - 1), qr, negm, r32, hi);
    finishSM(pA0, pA1, l_reg, pa0, pa1, pa2, pa3); SBAR();
    pv_d0(o, vb0 + SLOT(NT - 2), pa0, pa1, pa2, pa3); partialSM(pB0);
    finishSM(pB0, pB1, l_reg, pa0, pa1, pa2, pa3); SBAR();
    pv_d0(o, vb0 + SLOT(NT - 1), pa0, pa1, pa2, pa3);
    { auto rr = __builtin_amdgcn_permlane32_swap(__float_as_uint(l_reg), __float_as_uint(l_reg), false, false); l_reg = __uint_as_float(rr[0]) + __uint_as_float(rr[1]); }
    if (hi == 0) li_l[r32] = l_reg; asm volatile("s_waitcnt lgkmcnt(0)" ::: "memory");
    float rli[16];
#pragma unroll
    for (int r = 0; r < 16; ++r) rli[r] = __builtin_amdgcn_rcpf(li_l[crow(r, hi)]);
    bf16* Ow = Ob + (long)(wid * QBLK) * LDO;
    {
        bf16* stg = (bf16*)(lds + OFF_OST) + wid * 2048;
#pragma unroll
        for (int r = 0; r < 16; ++r) { const int orow = crow(r, hi);
#pragma unroll
            for (int d0 = 0; d0 < 2; ++d0) stg[orow * 64 + d0 * 32 + r32] = (bf16)f2bf(o[d0][r] * rli[r]); }
        asm volatile("s_waitcnt lgkmcnt(0)" ::: "memory");
#pragma unroll
        for (int i = 0; i < 4; ++i) { const int row = i * 8 + (lane >> 3), ch = lane & 7; const u32x4 v = *(const u32x4*)(stg + row * 64 + ch * 8); *(u32x4*)(Ow + (long)row * LDO + ch * 8) = v; }
    }
    asm volatile("s_waitcnt vmcnt(0)" ::: "memory");
    __syncthreads();
#undef HALF
#undef DMA
#undef WBAR
#undef SLOT
}
#undef SBAR
}

constexpr int GT_PITCH = 136;
struct GateRegs { u32x4 v0, v1; f32x4 sa, sb, sc, sd; u32x2 uu[4]; bf16x8 wf[8]; };
__device__ __forceinline__ void gate_phase(int bx, int G, bool skip_ctx, const bf16* __restrict__ VG, const bf16* __restrict__ U, const float* __restrict__ stats,
                                           const float* __restrict__ gsg, const float* __restrict__ bsg, const bf16* __restrict__ Wl, const float* __restrict__ bsl,
                                           bf16* __restrict__ MIX, char* lds) {
    const int tid = tid_fresh(), wid = tid >> 6, lane = tid & 63, r32 = lane & 31, hi = lane >> 5;
    bf16* T = (bf16*)lds;
    const int q = tid >> 2, dc = (tid & 3) * 16;
    const int db = wid & 1, pb = wid >> 1, p = pb * 32 + r32;
    const int NU = (M / 128) * 8;
    auto unit_ok = [&](int u) { return u < NU && !(skip_ctx && ((u >> 3) % 34) < 2); };
    auto next_unit = [&](int u) { u += G; while (u < NU && !unit_ok(u)) u += G; return u; };
    int u = bx; if (!unit_ok(u)) u = next_unit(u);
    GateRegs R;
#define GATE_LOAD(uu_) do { const int chunk_ = (uu_) >> 3, h_ = (uu_) & 7; const size_t rq = (size_t)chunk_ * 128 + q; \
        const float* st_ = stats + rq * 16; R.sa = *(const f32x4*)st_; R.sb = *(const f32x4*)(st_ + 4); R.sc = *(const f32x4*)(st_ + 8); R.sd = *(const f32x4*)(st_ + 12); \
        R.v0 = __builtin_nontemporal_load((const u32x4*)(VG + rq * 512 + h_ * 64 + dc)); R.v1 = __builtin_nontemporal_load((const u32x4*)(VG + rq * 512 + h_ * 64 + dc + 8)); \
        const size_t rp = (size_t)chunk_ * 128 + p; \
        _Pragma("unroll") for (int g4 = 0; g4 < 4; ++g4) R.uu[g4] = __builtin_nontemporal_load((const u32x2*)(U + rp * 512 + h_ * 64 + db * 32 + 8 * g4 + 4 * hi)); \
        const bf16* wrow_ = Wl + ((size_t)h_ * 128 + p) * 128 + hi * 8; \
        _Pragma("unroll") for (int ks = 0; ks < 8; ++ks) R.wf[ks] = *(const bf16x8*)(wrow_ + ks * 16); } while (0)
    if (u < NU) GATE_LOAD(u);
    while (u < NU) {
        const int chunk = u >> 3, h = u & 7;
        {
            const float s1 = (R.sa[0] + R.sa[2]) + (R.sb[0] + R.sb[2]) + (R.sc[0] + R.sc[2]) + (R.sd[0] + R.sd[2]);
            const float s2 = (R.sa[1] + R.sa[3]) + (R.sb[1] + R.sb[3]) + (R.sc[1] + R.sc[3]) + (R.sd[1] + R.sd[3]);
            const float mean = s1 * (1.0f / 512.0f);
            const float var = fmaxf(s2 * (1.0f / 512.0f) - mean * mean, 0.f);
            const float rstd = __builtin_amdgcn_rsqf(var + EPS);
            const float* gp = gsg + h * 64 + dc; const float* bp = bsg + h * 64 + dc;
#pragma unroll
            for (int i = 0; i < 8; ++i) {
                const unsigned w = i < 4 ? R.v0[i] : R.v1[i - 4];
                const float x0 = (bflo(w) - mean) * rstd * gp[2 * i] + bp[2 * i], x1 = (bfhi(w) - mean) * rstd * gp[2 * i + 1] + bp[2 * i + 1];
                T[(dc + 2 * i) * GT_PITCH + q] = (bf16)f2bf(x0); T[(dc + 2 * i + 1) * GT_PITCH + q] = (bf16)f2bf(x1);
            }
        }
        u32x2 ucur[4]; bf16x8 wcur[8];
#pragma unroll
        for (int g4 = 0; g4 < 4; ++g4) ucur[g4] = R.uu[g4];
#pragma unroll
        for (int ks = 0; ks < 8; ++ks) wcur[ks] = R.wf[ks];
        const float bias = bsl[h * 128 + p];
        const int un = next_unit(u);
        if (un < NU) GATE_LOAD(un);
        __syncthreads();
        f32x16 acc = {};
        const bf16* trow = T + (db * 32 + r32) * GT_PITCH + hi * 8;
#pragma unroll
        for (int ks = 0; ks < 8; ++ks) {
            const bf16x8 av = *(const bf16x8*)(trow + ks * 16);
            acc = __builtin_amdgcn_mfma_f32_32x32x16_bf16(av, wcur[ks], acc, 0, 0, 0);
        }
        const size_t row = (size_t)chunk * 128 + p;
#pragma unroll
        for (int g4 = 0; g4 < 4; ++g4) {
            const int d0 = db * 32 + 8 * g4 + 4 * hi;
            u32x2 w;
            w.x = pk2(bflo(ucur[g4].x) * (acc[4 * g4 + 0] + bias), bfhi(ucur[g4].x) * (acc[4 * g4 + 1] + bias));
            w.y = pk2(bflo(ucur[g4].y) * (acc[4 * g4 + 2] + bias), bfhi(ucur[g4].y) * (acc[4 * g4 + 3] + bias));
            *(u32x2*)(MIX + row * 1024 + 512 + h * 64 + d0) = w;
        }
        __syncthreads();
        u = un;
    }
#undef GATE_LOAD
}

struct RowPass { const float* x_in; const float* ctx_in; float* out; float* xc; const bf16* Y; bf16* H; const float* mod;
                 const float* gpost; const float* gpre; int init, update, norm_out, lg, gi, ln, si, skip_ctx; };
__device__ __forceinline__ void row_pass(const RowPass& R, int gw, int ngw, int lane) {
    constexpr int NR = 2;
    for (int row0 = gw; row0 < M; row0 += NR * ngw) {
        f32x4 v[NR][4]; u32x2 yw[NR][4]; bool act[NR]; float* xrow[NR]; int bbs[NR];
#pragma unroll
        for (int k = 0; k < NR; ++k) {
            const int row = row0 + k * ngw;
            const int rowc = row < M ? row : row0;
            const int b = rowc / RPB, i = rowc - b * RPB; const bool isctx = i < CTXL;
            act[k] = (row < M) && !(isctx && R.skip_ctx);
            bbs[k] = isctx ? 8 : b;
            xrow[k] = isctx ? R.xc + ((size_t)b * CTXL + i) * DM : R.out + ((size_t)b * SEQ + (i - CTXL)) * DM;
            const float* src = R.init ? (isctx ? R.ctx_in + ((size_t)b * CTXL + i) * DM : R.x_in + ((size_t)b * SEQ + (i - CTXL)) * DM) : xrow[k];
            if (act[k]) {
#pragma unroll
                for (int j = 0; j < 4; ++j) v[k][j] = __builtin_nontemporal_load((const f32x4*)(src + lane * 4 + 256 * j));
                if (R.update) { const bf16* yr = R.Y + (size_t)rowc * DM;
#pragma unroll
                    for (int j = 0; j < 4; ++j) yw[k][j] = __builtin_nontemporal_load((const u32x2*)(yr + lane * 4 + 256 * j)); }
            }
        }
#pragma unroll
        for (int k = 0; k < NR; ++k) {
            if (!act[k]) continue;
            const int row = row0 + k * ngw, bb = bbs[k];
            if (R.update) {
                f32x4 y[4]; float ss = 0.f;
#pragma unroll
                for (int j = 0; j < 4; ++j) { const u32x2 w = yw[k][j]; y[j] = (f32x4){bflo(w.x), bfhi(w.x), bflo(w.y), bfhi(w.y)};
                    ss += (y[j][0] * y[j][0] + y[j][1] * y[j][1]) + (y[j][2] * y[j][2] + y[j][3] * y[j][3]); }
                const float rstd = __builtin_amdgcn_rsqf(wave_sum(ss) * (1.0f / DM) + EPS);
                const float* gate = R.mod + ((size_t)(R.lg * 9 + bb) * NMOD + R.gi) * DM;
#pragma unroll
                for (int j = 0; j < 4; ++j) { const f32x4 g = *(const f32x4*)(gate + lane * 4 + 256 * j), gp = *(const f32x4*)(R.gpost + lane * 4 + 256 * j);
                    v[k][j] = v[k][j] + g * (y[j] * rstd * gp); }
            }
            if (R.init || R.update) {
#pragma unroll
                for (int j = 0; j < 4; ++j) __builtin_nontemporal_store(v[k][j], (f32x4*)(xrow[k] + lane * 4 + 256 * j));
            }
            if (R.norm_out) {
                float ss = 0.f;
#pragma unroll
                for (int j = 0; j < 4; ++j) ss += (v[k][j][0] * v[k][j][0] + v[k][j][1] * v[k][j][1]) + (v[k][j][2] * v[k][j][2] + v[k][j][3] * v[k][j][3]);
                const float rstd = __builtin_amdgcn_rsqf(wave_sum(ss) * (1.0f / DM) + EPS);
                const float* shift = R.mod + ((size_t)(R.ln * 9 + bb) * NMOD + R.si) * DM; const float* scale = shift + DM;
                bf16* hr = R.H + (size_t)row * DM;
#pragma unroll
                for (int j = 0; j < 4; ++j) { const f32x4 gp = *(const f32x4*)(R.gpre + lane * 4 + 256 * j), sh = *(const f32x4*)(shift + lane * 4 + 256 * j), sc = *(const f32x4*)(scale + lane * 4 + 256 * j);
                    const f32x4 hv = (v[k][j] * rstd * gp) * (sc + 1.0f) + sh;
                    u32x2 w; w.x = pk2(hv[0], hv[1]); w.y = pk2(hv[2], hv[3]); *(u32x2*)(hr + lane * 4 + 256 * j) = w; }
            }
        }
    }
}

__device__ __forceinline__ int rowmap(int mode, int n0) {
    if (mode == 1) { const int pn = n0 >> 8, q = n0 & 255; return pn * 256 + 128 * ((q & 63) >> 5) + 32 * (q >> 6); }
    if (mode == 2) { const int bj = n0 >= FFH ? 1 : 0, r = n0 - bj * FFH; return (r >> 7) * 256 + bj * 128 + (r & 127); }
    return n0;
}
__device__ __forceinline__ void transpose_item(const float* __restrict__ W, int K, int N, bf16* __restrict__ WT, int mode, LAS float* scr, int item, int lane) {
    const int nblk = N / 32, kb = item / nblk, nb = item % nblk, k0 = 64 * kb, n0 = 32 * nb;
#pragma unroll 8
    for (int i = 0; i < 32; ++i) { const int kk = 2 * i + (lane >> 5); scr[kk * 33 + (lane & 31)] = __builtin_nontemporal_load(W + (size_t)(k0 + kk) * N + n0 + (lane & 31)); }
    asm volatile("s_waitcnt lgkmcnt(0)" ::: "memory");
    const int c = lane & 7; const int r0 = rowmap(mode, n0);
#pragma unroll
    for (int j = 0; j < 4; ++j) { const int n = (lane >> 3) + 8 * j; const LAS float* s = scr + (8 * c) * 33 + n;
        u32x4 o; o.x = pk2(s[0 * 33], s[1 * 33]); o.y = pk2(s[2 * 33], s[3 * 33]); o.z = pk2(s[4 * 33], s[5 * 33]); o.w = pk2(s[6 * 33], s[7 * 33]);
        *(u32x4*)(WT + (size_t)(r0 + n) * K + k0 + 8 * c) = o; }
    asm volatile("s_waitcnt lgkmcnt(0)" ::: "memory");
}

__device__ __forceinline__ void convert_weights(ArgP A, unsigned char* lds_g, int gw, int NGW, int l0, int l1, int lane, int wave) {
    unsigned char* ws = A->ws;
    LAS float* scr = (LAS float*)((LAS unsigned char*)lds_g + wave * 8704);
    constexpr int I_IN = (DM / 64) * (INW / 32), I_OUT = (DM / 64) * (DM / 32), I_F1 = (DM / 64) * (FF2 / 32), I_F2 = (FFH / 64) * (DM / 32);
    constexpr int PER_L = I_IN + I_OUT + I_F1 + I_F2;
    for (int it = l0 * PER_L + gw; it < l1 * PER_L; it += NGW) {
        const int l = it / PER_L; int r = it - l * PER_L;
        if (r < I_IN) { transpose_item(A->w_in + (size_t)l * DM * INW, DM, INW, (bf16*)(ws + WS_WIN) + (size_t)l * INW * DM, 1, scr, r, lane); continue; } r -= I_IN;
        if (r < I_OUT) { transpose_item(A->w_out + (size_t)l * DM * DM, DM, DM, (bf16*)(ws + WS_WOUT) + (size_t)l * DM * DM, 0, scr, r, lane); continue; } r -= I_OUT;
        if (r < I_F1) { transpose_item(A->w_ffn_in + (size_t)l * DM * FF2, DM, FF2, (bf16*)(ws + WS_WF1) + (size_t)l * FF2 * DM, 2, scr, r, lane); continue; } r -= I_F1;
        transpose_item(A->w_ffn_out + (size_t)l * FFH * DM, FFH, DM, (bf16*)(ws + WS_WF2) + (size_t)l * DM * FFH, 0, scr, r, lane);
    }
}
__device__ __forceinline__ void prologue(ArgP A, unsigned char* lds_g, int vcu, int G) {
    const int tid = tid_fresh(), lane = tid & 63, wave = tid >> 6;
    unsigned char* ws = A->ws;
    convert_weights(A, lds_g, vcu * NWAVES + wave, G * NWAVES, 0, G == 256 ? 1 : DEPTH, lane, wave);
    {
        const int gt = vcu * NTHR + tid, NGT = G * NTHR;
        const int n4 = DEPTH * 8 * 128 * 128 / 4;
        bf16* wsb = (bf16*)(ws + WS_WS);
        for (int i = gt; i < n4; i += NGT) { const f32x4 v = *(const f32x4*)(A->w_s + (size_t)i * 4); u32x2 w; w.x = pk2(v[0], v[1]); w.y = pk2(v[2], v[3]); *(u32x2*)(wsb + (size_t)i * 4) = w; }
        if (gt < 1024) { const int pos = gt >> 4, f = gt & 15; const float inv = __builtin_amdgcn_exp2f(-(float)f * (13.287712379549449f / 16.0f)); const float ang = (float)pos * inv;
            float* rc = (float*)(ws + WS_ROPE); rc[gt] = __cosf(ang); rc[1024 + gt] = __sinf(ang); }
    }
    __syncthreads();
    {
        float* sil = (float*)lds_g;
        float* red = (float*)lds_g + 9 * 1024;
        for (int i = tid; i < 9 * 1024; i += NTHR) { const float cv = i < 8 * 1024 ? A->c[i] : A->c_ctx[i - 8 * 1024]; sil[i] = cv / (1.0f + __expf(-cv)); }
        __syncthreads();
        const int kg = tid >> 6, n = tid & 63;
        constexpr int NU = DEPTH * (NMOD * DM / 64);
        for (int un = vcu; un < NU; un += G) {
            const int l = un / (NMOD * DM / 64), cb = (un % (NMOD * DM / 64)) * 64;
            const float* wp = A->w_mod + ((size_t)l * DM + kg * 128) * (NMOD * DM) + cb + n;
            float acc[9];
#pragma unroll
            for (int bb = 0; bb < 9; ++bb) acc[bb] = 0.f;
#pragma unroll 2
            for (int k = 0; k < 128; k += 4) {
                const float w0 = __builtin_nontemporal_load(wp + (size_t)(k + 0) * (NMOD * DM)), w1 = __builtin_nontemporal_load(wp + (size_t)(k + 1) * (NMOD * DM)), w2 = __builtin_nontemporal_load(wp + (size_t)(k + 2) * (NMOD * DM)), w3 = __builtin_nontemporal_load(wp + (size_t)(k + 3) * (NMOD * DM));
#pragma unroll
                for (int bb = 0; bb < 9; ++bb) { const f32x4 s = *(const f32x4*)(sil + bb * 1024 + kg * 128 + k); acc[bb] += (s[0] * w0 + s[1] * w1) + (s[2] * w2 + s[3] * w3); }
            }
#pragma unroll
            for (int bb = 0; bb < 9; ++bb) red[(kg * 9 + bb) * 64 + n] = acc[bb];
            __syncthreads();
            for (int o = tid; o < 9 * 64; o += NTHR) { const int bb = o >> 6, nn = o & 63; float s = 0.f;
#pragma unroll
                for (int g = 0; g < 8; ++g) s += red[(g * 9 + bb) * 64 + nn];
                ((float*)(ws + WS_MOD))[((size_t)(l * 9 + bb)) * (NMOD * DM) + cb + nn] = s + A->b_mod[(size_t)l * NMOD * DM + cb + nn]; }
            __syncthreads();
        }
    }
}

constexpr int N_PHASES = 2 + 7 * DEPTH;
__global__ void __launch_bounds__(NTHR, 2) fwd_kernel(Args A_) {
    extern __shared__ __attribute__((aligned(16))) unsigned char lds[];
    cg::grid_group grid = cg::this_grid();
    const int G = gridDim.x, bx = blockIdx.x;
    volatile LAS unsigned* MISC = (volatile LAS unsigned*)((LAS unsigned char*)lds + LDS_STAGE);
    if (threadIdx.x < 8) MISC[threadIdx.x] = 0u;
    __syncthreads();
    (void)xcd_barrier_post((unsigned*)(A_.ws + WS_BAR), MISC);
    const int vcu = (G % 8 == 0) ? (bx % 8) * (G / 8) + bx / 8 : bx;
#ifndef PROBE_DUP
#define PROBE_DUP 0
#endif
#pragma unroll 1
    for (int st = A_.ph_lo * 2; st < A_.ph_hi * 2; ++st) {
        const int ph = st >> 1;
        ArgP A = (ArgP)__builtin_amdgcn_kernarg_segment_ptr(); asm volatile("" : "+s"(A));
        {
            const int ptype = ph == 0 ? 0 : ph == 1 ? 7 : 1 + (ph - 2) % 7;
            if ((st & 1) && !((PROBE_DUP >> ptype) & 1) && !((PROBE_DUP >> 8) & 1)) continue;
        }
        const int tid = tid_fresh(), lane = tid & 63, wave = __builtin_amdgcn_readfirstlane(tid >> 6);
        const int gw = vcu * NWAVES + wave, ngw = G * NWAVES;
        unsigned char* const ws = A->ws;
        bf16* const Hb = (bf16*)(ws + WS_H); bf16* const Yb = (bf16*)(ws + WS_Y); bf16* const HIDb = (bf16*)(ws + WS_BIG);
        bf16* const Qb = (bf16*)(ws + WS_Q); bf16* const Kb = (bf16*)(ws + WS_K); bf16* const Vb = (bf16*)(ws + WS_V); bf16* const Ub = (bf16*)(ws + WS_U); bf16* const VGb = (bf16*)(ws + WS_VG); bf16* const MIXb = (bf16*)(ws + WS_MIX);
        float* const modp = (float*)(ws + WS_MOD); float* const statp = (float*)(ws + WS_STATS); float* const xc = (float*)(ws + WS_XC);
        if ((st & 1) && ((PROBE_DUP >> 8) & 1)) {
        } else
        if (ph == 0) {
            prologue(A, lds, vcu, G);
        } else if (ph == 1) {
            RowPass R{A->x, A->ctx, A->out, xc, nullptr, Hb, modp, nullptr, A->g_pre_mix, 1, 0, 1, 0, 0, 0, 0, 0};
            row_pass(R, gw, ngw, lane);
        } else {
            const int l = (ph - 2) / 7, s = (ph - 2) % 7;
            if (s == 0) {
                pg8::Gemm g{Hb, (const bf16*)(ws + WS_WIN) + (size_t)l * INW * DM, M, INW, DM}; RowOrder S; S.init(INW, G, bx, 0);
                EpiInProj E{ws, A->g_q + l * 64, A->g_k + l * 64};
                pg8::gemm_phase<EpiInProj, RowOrder, true, true>((LAS unsigned char*)lds, g, S, E);
            } else if (s == 1) {
                const bool lastl = (l == DEPTH - 1);
                float gqm = fabsf(A->g_q[l * 64 + lane]), gkm = fabsf(A->g_k[l * 64 + lane]);
#pragma unroll
                for (int o = 1; o < 64; o <<= 1) { gqm = fmaxf(gqm, __shfl_xor(gqm, o)); gkm = fmaxf(gkm, __shfl_xor(gkm, o)); }
                const float m0l2 = 8.0f * 1.4426950408889634f * gqm * gkm;
                const bool chain = (G == 256);
                const bool hasctx = bx < 64 && !lastl;
                for (int i = 0; ; ++i) {
                    const int u = bx + i * G; if (u >= NB * 16 * 8) break;
                    const int b = u & 7, rest = u >> 3, h = rest & 7, qb = rest >> 3;
                    const size_t r0 = (size_t)b * RPB;
                    const bool more = (u + G < NB * 16 * 8) || hasctx;
                    att::attn_body(Qb + (r0 + CTXL + qb * 256) * 512 + h * 64, Kb + r0 * 128 + (h >> 2) * 64, Vb + r0 * 128 + (h >> 2) * 64,
                                   MIXb + (r0 + CTXL + qb * 256) * 1024 + h * 64, RPB, m0l2, (char*)lds, chain && i > 0, chain && more);
                }
                if (hasctx) {
                    const int b = bx & 7, h = bx >> 3; const size_t r0 = (size_t)b * RPB;
                    att::attn_body(Qb + r0 * 512 + h * 64, Kb + r0 * 128 + (h >> 2) * 64, Vb + r0 * 128 + (h >> 2) * 64, MIXb + r0 * 1024 + h * 64, CTXL, m0l2, (char*)lds, chain, false);
                }
                for (int grep_ = 0; grep_ < (((PROBE_DUP >> 9) & 1) ? 2 : 1); ++grep_)
                    gate_phase(bx, G, lastl, VGb, Ub, statp, A->g_sg + l * 512, A->b_sg + l * 512, (const bf16*)(ws + WS_WS) + (size_t)l * 8 * 128 * 128, A->b_s + l * 8 * 128, MIXb, (char*)lds);
            } else if (s == 2 || s == 5) {
                pg8::Gemm g = (s == 2) ? pg8::Gemm{MIXb, (const bf16*)(ws + WS_WOUT) + (size_t)l * DM * DM, M, DM, DM}
                                       : pg8::Gemm{HIDb, (const bf16*)(ws + WS_WF2) + (size_t)l * DM * FFH, M, DM, FFH};
                RowOrder S; S.init(DM, G, bx, (l == DEPTH - 1) || (s == 5 && G == 256));
                pg8::EpiBf16<0> E{Yb, DM, nullptr, 0, 0, 1.f};
                pg8::gemm_phase<pg8::EpiBf16<0>, RowOrder, true, true>((LAS unsigned char*)lds, g, S, E);
                if (s == 2 && G == 256 && l + 1 < DEPTH && bx >= 32)
                    convert_weights(A, lds, (bx - 32) * NWAVES + wave, (G - 32) * NWAVES, l + 1, l + 2, lane, wave);
            } else if (s == 3) {
                RowPass R{A->x, A->ctx, A->out, xc, Yb, Hb, modp, A->g_post_mix + l * DM, A->g_pre_ffn + l * DM, 0, 1, 1, l, 2, l, 3, l == DEPTH - 1};
                row_pass(R, gw, ngw, lane);
                if ((PROBE_DUP >> 10) & 1) { RowPass R2{A->x, A->ctx, A->out, xc, Yb, Hb, modp, A->g_post_mix + l * DM, A->g_pre_ffn + l * DM, 0, 0, 1, l, 2, l, 3, l == DEPTH - 1}; row_pass(R2, gw, ngw, lane); }
            } else if (s == 4) {
                pg8::Gemm g{Hb, (const bf16*)(ws + WS_WF1) + (size_t)l * FF2 * DM, M, FF2, DM};
                EpiSwiglu E{HIDb};
                if (l == DEPTH - 1 || G != 256) {
                    RowOrder S; S.init(FF2, G, bx, l == DEPTH - 1);
                    pg8::gemm_phase<EpiSwiglu, RowOrder, true, true>((LAS unsigned char*)lds, g, S, E);
                } else {
                    unsigned* cnt = (unsigned*)(ws + WS_BAR) + CW_G3C + 64 * l;
                    G3Order S; S.init(bx, cnt);
                    pg8::gemm_phase<EpiSwiglu, G3Order, true, true>((LAS unsigned char*)lds, g, S, E);
                    if (bx < 32) {
                        pg8::Gemm g2{HIDb, (const bf16*)(ws + WS_WF2) + (size_t)l * DM * FFH, M, DM, FFH};
                        CtxOneOrder S2{bx, cnt, 176u * 8u};
                        pg8::EpiBf16<0> E2{Yb, DM, nullptr, 0, 0, 1.f};
                        pg8::gemm_phase<pg8::EpiBf16<0>, CtxOneOrder, true, true>((LAS unsigned char*)lds, g2, S2, E2);
                    }
                }
            } else {
                const int last = (l == DEPTH - 1);
                RowPass R{A->x, A->ctx, A->out, xc, Yb, Hb, modp, A->g_post_ffn + l * DM, A->g_pre_mix + (last ? l : l + 1) * DM, 0, 1, last ? 0 : 1, l, 5, last ? l : l + 1, 0, last};
                row_pass(R, gw, ngw, lane);
            }
        }
        if (st + 1 < A_.ph_hi * 2) { if (A_.ph_hi < 0) grid.sync(); else { XcdBarrier bar; bar.bar = (unsigned*)(A->ws + WS_BAR); bar.x = xb_xcc_id(); bar.st = (volatile LAS unsigned*)((LAS unsigned char*)lds + LDS_STAGE); xcd_barrier(bar); } }
    }
}

#ifndef N_LAUNCH_MODE
#define N_LAUNCH_MODE 1
#endif
extern "C" void kernel_launch(void* const* d_in, const int* in_sizes, int n_in, void* d_out, int out_size, void* d_ws, size_t ws_size, hipStream_t stream) {
    static int grid = 0;
    if (grid == 0) {
        if (n_in != 20 || ws_size < WS_TOTAL) { fprintf(stderr, "kernel_launch: n_in %d ws %zu (need %zu)\n", n_in, ws_size, (size_t)WS_TOTAL); grid = -1; return; }
        int dev = 0, cus = 0, per_cu = 0;
        hipGetDevice(&dev); hipDeviceGetAttribute(&cus, hipDeviceAttributeMultiprocessorCount, dev);
        if (hipFuncSetAttribute((const void*)fwd_kernel, hipFuncAttributeMaxDynamicSharedMemorySize, LDS_BYTES) != hipSuccess) { fprintf(stderr, "kernel_launch: hipFuncSetAttribute failed\n"); grid = -1; return; }
        if (hipOccupancyMaxActiveBlocksPerMultiprocessor(&per_cu, (const void*)fwd_kernel, NTHR, LDS_BYTES) != hipSuccess || per_cu < 1) { fprintf(stderr, "kernel_launch: occupancy query gave %d\n", per_cu); per_cu = 1; }
        (void)hipGetLastError();
        grid = cus;
    }
    if (grid < 0) return;
    if (hipMemsetAsync((char*)d_ws + WS_BAR, 0, BAR_BYTES, stream) != hipSuccess) { fprintf(stderr, "kernel_launch: memset failed\n"); return; }
    Args a{};
    const float** ap = (const float**)&a;
    for (int i = 0; i < 20; ++i) ap[i] = (const float*)d_in[i];
    a.out = (float*)d_out; a.ws = (unsigned char*)d_ws;
#if N_LAUNCH_MODE == 1
    a.ph_lo = 0; a.ph_hi = N_PHASES;
    void* args[] = {&a};
    hipError_t e = hipLaunchCooperativeKernel((const void*)fwd_kernel, dim3(grid), dim3(NTHR), args, LDS_BYTES, stream);
    if (e != hipSuccess) fprintf(stderr, "cooperative launch failed: %s (grid %d)\n", hipGetErrorString(e), grid);
#else
    for (int p = 0; p < N_PHASES; ++p) { a.ph_lo = p; a.ph_hi = p + 1; hipLaunchKernelGGL(fwd_kernel, dim3(grid), dim3(NTHR), LDS_BYTES, stream, a); }
#endif
}
```

```cpp
#include <hip/hip_runtime.h>
#include <cstdio>
#include <cstdint>
__device__ __forceinline__ int tid_fresh() { int t = threadIdx.x; asm volatile("" : "+v"(t)); return t; }
namespace pg8 {
#define PG8_LAS __attribute__((address_space(3)))
typedef unsigned short bf16_t;
typedef short bf16x8 __attribute__((ext_vector_type(8)));
typedef float f32x4 __attribute__((ext_vector_type(4)));
typedef unsigned u32x4 __attribute__((ext_vector_type(4)));
constexpr int BM = 256, BK = 64, HALF = 128, HTB = HALF * BK * 2  , STAGE_BYTES = 8 * HTB, NXCD = 8, WGM = 8;

__host__ __device__ __forceinline__ int lds_byte(int r, int c) { const int st = (r >> 4) * 2 + (c >> 5), rr = r & 15, cc = c & 31, ob = rr * 64 + cc * 2; return st * 1024 + (ob ^ (((ob >> 9) & 1) << 5)); }
__host__ __device__ __forceinline__ void stage_rc(int b, int& R, int& C) { const int st = b / 1024, sb = b % 1024, swz = sb ^ (((sb >> 9) & 1) << 5); R = (st >> 1) * 16 + swz / 64; C = (st & 1) * 32 + (swz % 64) / 2; }
__host__ __device__ __forceinline__ int perm32(int rho) { const int n = rho >> 4, i = rho & 15; return 8 * (i >> 2) + 4 * n + (i & 3); }

struct Unit { int pm, pn; };
struct Gemm { const bf16_t* A; const bf16_t* Bt; int M, N, K; };

struct StaticOrder {
    int nM, nN, nwg, G, c;
    __host__ __device__ void init(int M, int N, int G_, int c_) { nM = M / BM; nN = N / BM; nwg = nM * nN; G = G_; c = c_; }
    __host__ __device__ bool next(int i, Unit& u) const {
        const long L = (long)i * G + c; if (L >= nwg) return false;
        int wgid = (int)L; { const int q = nwg / NXCD, r = nwg % NXCD, xcd = wgid % NXCD, off = wgid / NXCD; wgid = (xcd < r ? xcd * (q + 1) : r * (q + 1) + (xcd - r) * q) + off; }
        const int nig = WGM * nN, gid = wgid / nig, fm = gid * WGM, gsz = (nM - fm) < WGM ? (nM - fm) : WGM;
        u.pm = fm + ((wgid % nig) % gsz); u.pn = (wgid % nig) / gsz; return true;
    }
    __device__ __forceinline__ void a_ready(const Unit&) const {}
    __device__ __forceinline__ void done(const Unit&) const {}
};

__device__ __forceinline__ unsigned cvt_pk_bf16(float lo, float hi) { unsigned r; asm volatile("v_cvt_pk_bf16_f32 %0, %1, %2" : "=v"(r) : "v"(lo), "v"(hi)); return r; }
typedef float f32x2 __attribute__((ext_vector_type(2)));
__device__ __forceinline__ f32x2 gelu_pk(f32x2 v) {
    const f32x2 av = __builtin_elementwise_abs(v), d = av * 0.2316418882f + 1.0f;
    f32x2 t; t.x = __builtin_amdgcn_rcpf(d.x); t.y = __builtin_amdgcn_rcpf(d.y);
    f32x2 q = t * 0.5307027145f + (-0.7265760135f); q = q * t + 0.7107068705f; q = q * t + (-0.142248368f); q = q * t + 0.127414796f; q = q * t;
    const f32x2 s = (v * v) * (-0.72134752044f);
    f32x2 e; e.x = __builtin_amdgcn_exp2f(s.x); e.y = __builtin_amdgcn_exp2f(s.y);
    const f32x2 m = v * (q * e), r = v - m;
    f32x2 o; o.x = v.x < 0.f ? m.x : r.x; o.y = v.y < 0.f ? m.y : r.y; return o;
}

template <int ACT  > struct EpiBf16 {
    static constexpr bool PERM = true, AFTER_DRAIN = false; static_assert(ACT == 0 || ACT == 1, "EpiBf16: ACT is 0 (none) or 1 (gelu_pk)");
    bf16_t* O; int ldc; const float* bias; int split_cols; size_t split_stride; float scale0;
    __device__ __forceinline__ void operator()(const f32x4 (&acc)[2][2][4][2], const Unit& u, int wr, int wc, int fr, int fq) const {
        const int row0 = u.pm * BM + wr * 64 + fr; int colt = u.pn * BM; bf16_t* base = O;
        float sc = 1.f; if (split_cols) { const int t = colt / split_cols; base += (size_t)t * split_stride; colt -= t * split_cols; if (t == 0) sc = scale0; }
        const int col0 = colt + wc * 32 + 8 * fq, bcol0 = u.pn * BM + wc * 32 + 8 * fq;
        f32x4 bv[2][2];
#pragma unroll
        for (int bj = 0; bj < 2; ++bj)
#pragma unroll
            for (int n = 0; n < 2; ++n) bv[bj][n] = bias ? *(const f32x4*)(bias + bcol0 + bj * HALF + 4 * n) : (f32x4){0.f, 0.f, 0.f, 0.f};
#pragma unroll
        for (int ai = 0; ai < 2; ++ai)
#pragma unroll
            for (int m = 0; m < 4; ++m) { bf16_t* rowp = base + (size_t)(row0 + ai * HALF + m * 16) * ldc + col0;
#pragma unroll
                for (int bj = 0; bj < 2; ++bj) { f32x4 v0 = acc[ai][bj][m][0] + bv[bj][0], v1 = acc[ai][bj][m][1] + bv[bj][1];
                    if (ACT == 1) { f32x2 a = gelu_pk((f32x2){v0[0], v0[1]}), b = gelu_pk((f32x2){v0[2], v0[3]}), c = gelu_pk((f32x2){v1[0], v1[1]}), d = gelu_pk((f32x2){v1[2], v1[3]});
                        v0 = (f32x4){a.x, a.y, b.x, b.y}; v1 = (f32x4){c.x, c.y, d.x, d.y}; }
                    v0 = v0 * sc; v1 = v1 * sc; u32x4 w; w.x = cvt_pk_bf16(v0[0], v0[1]); w.y = cvt_pk_bf16(v0[2], v0[3]); w.z = cvt_pk_bf16(v1[0], v1[1]); w.w = cvt_pk_bf16(v1[2], v1[3]);
                    *(u32x4*)(rowp + bj * HALF) = w; } }
    }
};
template <class Epi, class Sched, bool ALIGN_EPI = false, bool SP2 = false>
__device__ __forceinline__ void gemm_phase(PG8_LAS unsigned char* lds, const Gemm g, const Sched& S, const Epi& E) {
    const int tid = tid_fresh(), wid = __builtin_amdgcn_readfirstlane(tid >> 6), lane = tid & 63, wr = wid >> 2, wc = wid & 3, fr = lane & 15, fq = lane >> 4;
    const int K = g.K, nt = K / BK;
    unsigned voffA[2], voffB[2];
#pragma unroll
    for (int i = 0; i < 2; ++i) { int R, C; stage_rc(tid * 16 + i * 8192, R, C); const int Rb = Epi::PERM ? ((R & ~31) + perm32(R & 31)) : R;
        voffA[i] = (unsigned)(R * K + C) * 2u; voffB[i] = (unsigned)(Rb * K + C) * 2u; }
    const size_t kstep = (size_t)(BK * 2);
    const size_t hstep = (size_t)HALF * K * 2;
    const size_t tstep = 2 * hstep;
    const unsigned ldsw = (unsigned)wid * 1024u;
    const int aoff = lds_byte(wr * 64 + fr, fq * 8), boff = lds_byte(wc * 32 + fr, fq * 8);
#define PG8_SA(b, h) (((b) * 2 + (h)) * HTB)
#define PG8_SB(b, h) ((4 + (b) * 2 + (h)) * HTB)
#define PG8_STAGE(bufoff, gbase, voff) do { _Pragma("unroll") for (int _i = 0; _i < 2; ++_i) \
        __builtin_amdgcn_global_load_lds((const unsigned*)((const char*)(gbase) + (voff)[_i]), (PG8_LAS unsigned*)(lds + (bufoff) + ldsw + _i * 8192), 16, 0, 0); } while (0)
#define PG8_LDA(dst, b, h) do { _Pragma("unroll") for (int m = 0; m < 4; ++m) _Pragma("unroll") for (int k = 0; k < 2; ++k) dst[m][k] = *(const PG8_LAS bf16x8*)(lds + PG8_SA(b, h) + aoff + m * 2048 + k * 1024); } while (0)
#define PG8_LDB(dst, b, h) do { _Pragma("unroll") for (int n = 0; n < 2; ++n) _Pragma("unroll") for (int k = 0; k < 2; ++k) dst[n][k] = *(const PG8_LAS bf16x8*)(lds + PG8_SB(b, h) + boff + n * 2048 + k * 1024); } while (0)
#define PG8_MMA(ai, bj, At, Bt) do { __builtin_amdgcn_s_setprio(1); _Pragma("unroll") for (int m = 0; m < 4; ++m) _Pragma("unroll") for (int n = 0; n < 2; ++n) _Pragma("unroll") for (int k = 0; k < 2; ++k) \
        acc[ai][bj][m][n] = __builtin_amdgcn_mfma_f32_16x16x32_bf16(Bt[n][k], At[m][k], acc[ai][bj][m][n], 0, 0, 0); __builtin_amdgcn_s_setprio(0); } while (0)
#define PG8_WAIT_V(n) asm volatile("s_waitcnt vmcnt(" #n ")" ::: "memory")
#define PG8_WAIT_L(n) asm volatile("s_waitcnt lgkmcnt(" #n ")" ::: "memory")
#define PG8_BAR __builtin_amdgcn_s_barrier()
#define PG8_SCHED __builtin_amdgcn_sched_barrier(0)
    Unit cur, nxt; int ui = 0;
    if (!S.next(0, cur)) return;
    f32x4 acc[2][2][4][2];
#pragma unroll
    for (int a = 0; a < 2; ++a)
#pragma unroll
        for (int b = 0; b < 2; ++b)
#pragma unroll
            for (int m = 0; m < 4; ++m)
#pragma unroll
                for (int n = 0; n < 2; ++n) acc[a][b][m][n] = (f32x4){0.f, 0.f, 0.f, 0.f};
    bf16x8 At[4][2], B0[2][2], B1[2][2];
    const char* cA = (const char*)g.A + (size_t)cur.pm * tstep; const char* cB = (const char*)g.Bt + (size_t)cur.pn * tstep;
    S.a_ready(cur);
    if constexpr (SP2) {
        PG8_STAGE(PG8_SB(0, 0), cB, voffB); PG8_STAGE(PG8_SB(0, 1), cB + hstep, voffB); PG8_STAGE(PG8_SA(0, 0), cA, voffA); PG8_STAGE(PG8_SA(0, 1), cA + hstep, voffA);
        if (wr == 1) PG8_BAR;
        PG8_WAIT_V(2); PG8_BAR;
        PG8_STAGE(PG8_SB(1, 0), cB + kstep, voffB); PG8_STAGE(PG8_SA(1, 0), cA + kstep, voffA); PG8_STAGE(PG8_SB(1, 1), cB + hstep + kstep, voffB);
        PG8_WAIT_V(6); PG8_BAR;
    } else {
        PG8_STAGE(PG8_SB(0, 0), cB, voffB); PG8_STAGE(PG8_SA(0, 0), cA, voffA); PG8_STAGE(PG8_SB(0, 1), cB + hstep, voffB); PG8_STAGE(PG8_SA(0, 1), cA + hstep, voffA);
        if (wr == 1) PG8_BAR;
        PG8_WAIT_V(4); PG8_BAR;
        PG8_STAGE(PG8_SB(1, 0), cB + kstep, voffB); PG8_STAGE(PG8_SA(1, 0), cA + kstep, voffA); PG8_STAGE(PG8_SB(1, 1), cB + hstep + kstep, voffB);
        PG8_WAIT_V(6); PG8_BAR;
    }
    for (;;) {
        const bool has_next = S.next(ui + 1, nxt);
        const char* nA = has_next ? (const char*)g.A + (size_t)nxt.pm * tstep : cA; const char* nB = has_next ? (const char*)g.Bt + (size_t)nxt.pn * tstep : cB;
        for (int t = 0; t < nt; t += 2) {
            const bool last = (t == nt - 2);
            const char* a1 = cA + (size_t)(t + 1) * kstep;
            const char* a2 = last ? nA : cA + (size_t)(t + 2) * kstep; const char* b2 = last ? nB : cB + (size_t)(t + 2) * kstep;
            const char* a3 = a2 + kstep; const char* b3 = b2 + kstep;
            if (last && has_next) S.a_ready(nxt);
            if constexpr (SP2) {
            PG8_LDB(B0, 0, 0); PG8_LDB(B1, 0, 1); PG8_SCHED; PG8_LDA(At, 0, 0); PG8_STAGE(PG8_SA(1, 1), a1 + hstep, voffA);
            PG8_WAIT_V(8); PG8_WAIT_L(0); PG8_BAR; PG8_MMA(0, 0, At, B0); PG8_MMA(0, 1, At, B1); PG8_BAR; PG8_SCHED;
            PG8_LDA(At, 0, 1); PG8_STAGE(PG8_SB(0, 0), b2, voffB); PG8_STAGE(PG8_SB(0, 1), b2 + hstep, voffB); PG8_STAGE(PG8_SA(0, 0), a2, voffA);
            PG8_WAIT_V(8); PG8_WAIT_L(0); PG8_BAR; PG8_MMA(1, 0, At, B0); PG8_MMA(1, 1, At, B1); PG8_BAR; PG8_SCHED;
            PG8_LDB(B0, 1, 0); PG8_LDB(B1, 1, 1); PG8_SCHED; PG8_LDA(At, 1, 0); PG8_STAGE(PG8_SA(0, 1), a2 + hstep, voffA);
            PG8_WAIT_V(8); PG8_WAIT_L(0); PG8_BAR; PG8_MMA(0, 0, At, B0); PG8_MMA(0, 1, At, B1); PG8_BAR; PG8_SCHED;
            PG8_LDA(At, 1, 1); PG8_STAGE(PG8_SB(1, 0), b3, voffB); PG8_STAGE(PG8_SB(1, 1), b3 + hstep, voffB); PG8_STAGE(PG8_SA(1, 0), a3, voffA);
            PG8_WAIT_V(8); PG8_WAIT_L(0); PG8_BAR; PG8_MMA(1, 0, At, B0); PG8_MMA(1, 1, At, B1); PG8_BAR; PG8_SCHED;
            } else {
            PG8_LDB(B0, 0, 0); PG8_SCHED; PG8_LDA(At, 0, 0); PG8_STAGE(PG8_SA(1, 1), a1 + hstep, voffA);
            PG8_WAIT_L(8); PG8_BAR; PG8_WAIT_L(0); PG8_MMA(0, 0, At, B0); PG8_BAR; PG8_SCHED;
            PG8_LDB(B1, 0, 1); PG8_STAGE(PG8_SB(0, 0), b2, voffB);
            PG8_BAR; PG8_WAIT_L(0); PG8_MMA(0, 1, At, B1); PG8_BAR;
            PG8_LDA(At, 0, 1); PG8_STAGE(PG8_SA(0, 0), a2, voffA);
            PG8_BAR; PG8_WAIT_L(0); PG8_MMA(1, 0, At, B0); PG8_BAR; PG8_SCHED;
            PG8_STAGE(PG8_SB(0, 1), b2 + hstep, voffB);
            PG8_WAIT_V(6); PG8_BAR; PG8_MMA(1, 1, At, B1); PG8_BAR;
            PG8_LDB(B0, 1, 0); PG8_SCHED; PG8_LDA(At, 1, 0); PG8_STAGE(PG8_SA(0, 1), a2 + hstep, voffA);
            PG8_WAIT_L(8); PG8_BAR; PG8_WAIT_L(0); PG8_MMA(0, 0, At, B0); PG8_BAR; PG8_SCHED;
            PG8_LDB(B1, 1, 1); PG8_STAGE(PG8_SB(1, 0), b3, voffB);
            PG8_BAR; PG8_WAIT_L(0); PG8_MMA(0, 1, At, B1); PG8_BAR;
            PG8_LDA(At, 1, 1); PG8_STAGE(PG8_SA(1, 0), a3, voffA);
            PG8_BAR; PG8_WAIT_L(0); PG8_MMA(1, 0, At, B0); PG8_BAR; PG8_SCHED;
            PG8_STAGE(PG8_SB(1, 1), b3 + hstep, voffB);
            PG8_WAIT_V(6); PG8_BAR; PG8_MMA(1, 1, At, B1); PG8_BAR;
            }
        }
        if constexpr (ALIGN_EPI) { if (wr == 0) PG8_BAR; }
        if constexpr (!Epi::AFTER_DRAIN) { E(acc, cur, wr, wc, fr, fq); S.done(cur); }
        if (!has_next) break;
#pragma unroll
        for (int a = 0; a < 2; ++a)
#pragma unroll
            for (int b = 0; b < 2; ++b)
#pragma unroll
                for (int m = 0; m < 4; ++m)
#pragma unroll
                    for (int n = 0; n < 2; ++n) acc[a][b][m][n] = (f32x4){0.f, 0.f, 0.f, 0.f};
        cur = nxt; cA = nA; cB = nB; ++ui;
        if constexpr (ALIGN_EPI) { if (wr == 1) PG8_BAR; }
    }
    PG8_WAIT_V(0);
    if constexpr (!ALIGN_EPI) { if (wr == 0) PG8_BAR; }
    PG8_BAR;
    if constexpr (Epi::AFTER_DRAIN) { E.fused(acc, cur, wr, wc, fr, fq, lds, wid, lane); S.done(cur); }
#undef PG8_SA
#undef PG8_SB
#undef PG8_STAGE
#undef PG8_LDA
#undef PG8_LDB
#undef PG8_MMA
#undef PG8_WAIT_V
#undef PG8_WAIT_L
#undef PG8_BAR
#undef PG8_SCHED
}
}

#include <hip/hip_cooperative_groups.h>
namespace cg = cooperative_groups;

#define LAS __attribute__((address_space(3)))
typedef unsigned short bf16;
typedef float f32x4 __attribute__((ext_vector_type(4)));
typedef float f32x16 __attribute__((ext_vector_type(16)));
typedef short bf16x8 __attribute__((ext_vector_type(8)));
typedef short s16x4 __attribute__((ext_vector_type(4)));
typedef unsigned u32x4 __attribute__((ext_vector_type(4)));
typedef unsigned u32x2 __attribute__((ext_vector_type(2)));

constexpr int DM = 1024, NB = 8, SEQ = 4096, CTXL = 256, DEPTH = 4;
constexpr int RPB = SEQ + CTXL;
constexpr int M = NB * RPB;
constexpr int INW = 1792, FFH = 2816, FF2 = 2 * FFH;
constexpr int NMOD = 6;
constexpr float EPS = 1e-6f;
constexpr int NWAVES = 8, NTHR = 512;
constexpr int LDS_STAGE = 131072, LDS_BYTES = LDS_STAGE + 256;

constexpr size_t al256(size_t x) { return (x + 255) / 256 * 256; }
constexpr size_t WS_WIN = 0;
constexpr size_t WS_WOUT = WS_WIN + al256((size_t)DEPTH * INW * DM * 2);
constexpr size_t WS_WF1 = WS_WOUT + al256((size_t)DEPTH * DM * DM * 2);
constexpr size_t WS_WF2 = WS_WF1 + al256((size_t)DEPTH * FF2 * DM * 2);
constexpr size_t WS_WS = WS_WF2 + al256((size_t)DEPTH * DM * FFH * 2);
constexpr size_t WS_MOD = WS_WS + al256((size_t)DEPTH * 8 * 128 * 128 * 2);
constexpr size_t WS_ROPE = WS_MOD + al256((size_t)DEPTH * 9 * NMOD * DM * 4);
constexpr size_t WS_STATS = WS_ROPE + al256(2 * 64 * 16 * 4);
constexpr size_t WS_XC = WS_STATS + al256((size_t)M * 16 * 4);
constexpr size_t WS_H = WS_XC + al256((size_t)NB * CTXL * DM * 4);
constexpr size_t WS_Y = WS_H + al256((size_t)M * DM * 2);
constexpr size_t WS_BIG = WS_Y + al256((size_t)M * DM * 2);
constexpr size_t WS_Q = WS_BIG;
constexpr size_t WS_K = WS_Q + (size_t)M * 512 * 2;
constexpr size_t WS_V = WS_K + (size_t)M * 128 * 2;
constexpr size_t WS_U = WS_V + (size_t)M * 128 * 2;
constexpr size_t WS_VG = WS_U + (size_t)M * 512 * 2;
constexpr size_t WS_MIX = WS_VG + (size_t)M * 512 * 2;
constexpr size_t WS_END = WS_BIG + al256((size_t)M * FFH * 2);
constexpr size_t WS_BAR = WS_END, BAR_BYTES = 16384, WS_TOTAL = WS_BAR + BAR_BYTES;
static_assert(WS_MIX + (size_t)M * DM * 2 <= WS_END, "overlay");

struct Args {
    const float *x, *c, *ctx, *c_ctx, *w_mod, *b_mod, *g_pre_mix, *g_post_mix, *g_pre_ffn, *g_post_ffn, *w_in, *g_q, *g_k, *g_sg, *b_sg, *w_s, *b_s, *w_out, *w_ffn_in, *w_ffn_out;
    float* out; unsigned char* ws; int ph_lo, ph_hi;
};

typedef const __attribute__((address_space(4))) Args* ArgP;

#define XB_TMO      128
#define XB_XCNT(j)  (256  + 64 * (j))
#define XB_XSUB(j)  (1280 + 64 * (j))
#define XB_XGEN(j)  (2304 + 64 * (j))
#define XB_TOP      3328
#define XB_TOPGEN   3392
#define XCD_BAR_WORDS 3456
#define XB_SPIN_CAP (1u << 18)

__device__ __forceinline__ unsigned xb_ld(unsigned* p)              { return __hip_atomic_load(p, __ATOMIC_RELAXED, __HIP_MEMORY_SCOPE_AGENT); }
__device__ __forceinline__ unsigned xb_add(unsigned* p, unsigned v) { return __hip_atomic_fetch_add(p, v, __ATOMIC_RELAXED, __HIP_MEMORY_SCOPE_AGENT); }
__device__ __forceinline__ unsigned xb_xcc_id() { return (unsigned)__builtin_amdgcn_s_getreg((3 << 11) | 20) & 0xFu; }
#define XB_SPIN(cond, bar) do { unsigned _sp = 0; while (cond) { __builtin_amdgcn_s_sleep(1); \
    if ((++_sp & 255u) == 0u) { if (xb_ld(&(bar)[XB_TMO])) break; if (_sp > XB_SPIN_CAP) { atomicAdd(&(bar)[XB_TMO], 1u); break; } } } } while (0)

struct XcdBarrier {
    unsigned* bar; unsigned x;
    volatile LAS unsigned* st;
};

__device__ __forceinline__ XcdBarrier xcd_barrier_post(unsigned* bar, volatile LAS unsigned* st) {
    XcdBarrier b; b.bar = bar; b.x = xb_xcc_id(); b.st = st;
    if (threadIdx.x == 0) (void)xb_add(&bar[XB_XCNT(b.x)], 1u);
    return b;
}
__device__ __forceinline__ void xcd_barrier_complete(unsigned* bar, unsigned x, unsigned& nloc, unsigned& nx) {
    const unsigned G = gridDim.x * gridDim.y * gridDim.z;
    unsigned sum, cnt, mine, sp = 0u;
    for (;;) {
        sum = 0u; cnt = 0u; mine = 0u;
#pragma unroll
        for (unsigned j = 0; j < 16; ++j) { const unsigned c = xb_ld(&bar[XB_XCNT(j)]); sum += c; cnt += (c > 0u) ? 1u : 0u; mine = (j == x) ? c : mine; }
        if (sum == G) break;
        __builtin_amdgcn_s_sleep(1);
        if ((++sp & 255u) == 0u) { if (xb_ld(&bar[XB_TMO])) break; if (sp > XB_SPIN_CAP) { atomicAdd(&bar[XB_TMO], 1u); break; } }
    }
    nloc = mine > 0u ? mine : 1u; nx = cnt > 0u ? cnt : 1u;
}

__device__ __forceinline__ void xcd_barrier(const XcdBarrier& b) {
    asm volatile("s_waitcnt vmcnt(0)" ::: "memory");
    __syncthreads();
    if (threadIdx.x == 0) {
        unsigned* bar = b.bar;
        __builtin_amdgcn_s_waitcnt(0);
        unsigned nloc = b.st[0], nx = b.st[1];
        if (nloc == 0u) { xcd_barrier_complete(bar, b.x, nloc, nx); b.st[0] = nloc; b.st[1] = nx; }
        const unsigned old = xb_add(&bar[XB_XSUB(b.x)], 1u);
        const unsigned gen = old / nloc;
        if (old + 1u == (gen + 1u) * nloc) {
            __builtin_amdgcn_fence(__ATOMIC_RELEASE, "agent");
            asm volatile("s_waitcnt vmcnt(0)" ::: "memory");
            const unsigned og = xb_add(&bar[XB_TOP], 1u);
            const unsigned tg = og / nx;
            if (og + 1u == (tg + 1u) * nx) xb_add(&bar[XB_TOPGEN], 1u);
            else XB_SPIN(xb_ld(&bar[XB_TOPGEN]) == tg, bar);
            __builtin_amdgcn_fence(__ATOMIC_ACQUIRE, "agent");
            xb_add(&bar[XB_XGEN(b.x)], 1u);
            asm volatile("s_waitcnt vmcnt(0)" ::: "memory");
        } else {
            XB_SPIN(xb_ld(&bar[XB_XGEN(b.x)]) == gen, bar);
            __builtin_amdgcn_fence(__ATOMIC_ACQUIRE, "agent");
            asm volatile("s_waitcnt vmcnt(0)" ::: "memory");
        }
    }
    __syncthreads();
}


__device__ __forceinline__ unsigned f2bf(float f) { unsigned u = __builtin_bit_cast(unsigned, f); return (u + 0x7fffu + ((u >> 16) & 1u)) >> 16; }
__device__ __forceinline__ unsigned pk2(float lo, float hi) { return pg8::cvt_pk_bf16(lo, hi); }
__device__ __forceinline__ float bflo(unsigned w) { return __uint_as_float(w << 16); }
__device__ __forceinline__ float bfhi(unsigned w) { return __uint_as_float(w & 0xffff0000u); }
__device__ __forceinline__ float wave_sum(float v) {
#pragma unroll
    for (int o = 1; o < 64; o <<= 1) v += __shfl_xor(v, o);
    return v;
}
__device__ __forceinline__ float gelu_tanh(float x) {
    const float u = x * (0.7978845608028654f + 0.035677408136300125f * x * x);
    return x * __builtin_amdgcn_rcpf(1.0f + __builtin_amdgcn_exp2f(-2.8853900817779268f * u));
}
__device__ __forceinline__ float silu_f(float x) { return x * __builtin_amdgcn_rcpf(1.0f + __builtin_amdgcn_exp2f(-1.4426950408889634f * x)); }

struct EpiInProj {
    static constexpr bool PERM = true, AFTER_DRAIN = false;
    unsigned char* wsb; const float *gq, *gk;
    __device__ __forceinline__ void operator()(const f32x4 (&acc)[2][2][4][2], const pg8::Unit& u, int wr, int wc, int fr, int fq) const {
        const int pm = u.pm, pn = u.pn;
        bf16* const Q = (bf16*)(wsb + WS_Q); bf16* const K = (bf16*)(wsb + WS_K); bf16* const V = (bf16*)(wsb + WS_V); bf16* const U = (bf16*)(wsb + WS_U); bf16* const VG = (bf16*)(wsb + WS_VG);
        float* const stats = (float*)(wsb + WS_STATS); const float* const ropec = (const float*)(wsb + WS_ROPE); const float* const ropes = ropec + 1024;
        const bool isctx = (pm % 17) == 0;
        const int seq0 = ((pm % 17) - 1) * 256;
        if (pn <= 2 && !(pn == 2 && wc >= 2)) {
            const bool isq = pn < 2;
            const float qscale = isq ? 0.125f * 1.4426950408889634f : 1.0f;
            const float* g = isq ? gq : gk;
            bf16* dst; int pitch, hcol;
            if (isq) { dst = Q; pitch = 512; hcol = (pn * 4 + wc) * 64; } else { dst = K; pitch = 128; hcol = wc * 64; }
            f32x4 gv[2][2];
#pragma unroll
            for (int bj = 0; bj < 2; ++bj)
#pragma unroll
                for (int n = 0; n < 2; ++n) gv[bj][n] = *(const f32x4*)(g + 32 * bj + 8 * fq + 4 * n);
            const int fbase = 8 * (fq & 1);
            const bool lowhalf = fq < 2;
#pragma unroll
            for (int ai = 0; ai < 2; ++ai)
#pragma unroll
                for (int m = 0; m < 4; ++m) {
                    const int rl = ai * 128 + wr * 64 + m * 16 + fr;
                    const int row = pm * 256 + rl;
                    float ss = 0.f;
#pragma unroll
                    for (int bj = 0; bj < 2; ++bj)
#pragma unroll
                        for (int n = 0; n < 2; ++n) { const f32x4 v = acc[ai][bj][m][n]; ss += (v[0] * v[0] + v[1] * v[1]) + (v[2] * v[2] + v[3] * v[3]); }
                    ss += __shfl_xor(ss, 16); ss += __shfl_xor(ss, 32);
                    const float rstd = __builtin_amdgcn_rsqf(ss * (1.0f / 64.0f) + EPS);
                    const int sp = seq0 + rl;
#pragma unroll
                    for (int bj = 0; bj < 2; ++bj) {
                        f32x4 y0 = acc[ai][bj][m][0] * (rstd * qscale) * gv[bj][0], y1 = acc[ai][bj][m][1] * (rstd * qscale) * gv[bj][1];
                        if (!isctx) {
                            const int pos = bj == 0 ? (sp >> 6) : (sp & 63);
                            const f32x4 c0 = *(const f32x4*)(ropec + pos * 16 + fbase), c1 = *(const f32x4*)(ropec + pos * 16 + fbase + 4);
                            const f32x4 s0 = *(const f32x4*)(ropes + pos * 16 + fbase), s1 = *(const f32x4*)(ropes + pos * 16 + fbase + 4);
                            f32x4 p0, p1;
#pragma unroll
                            for (int j = 0; j < 4; ++j) { p0[j] = __shfl_xor(y0[j], 32); p1[j] = __shfl_xor(y1[j], 32); }
                            if (lowhalf) { y0 = y0 * c0 - p0 * s0; y1 = y1 * c1 - p1 * s1; }
                            else         { y0 = p0 * s0 + y0 * c0; y1 = p1 * s1 + y1 * c1; }
                        }
                        u32x4 w; w.x = pk2(y0[0], y0[1]); w.y = pk2(y0[2], y0[3]); w.z = pk2(y1[0], y1[1]); w.w = pk2(y1[2], y1[3]);
                        *(u32x4*)(dst + (size_t)row * pitch + hcol + 32 * bj + 8 * fq) = w;
                    }
                }
        } else if (pn == 2) {
            const int hcol = (wc - 2) * 64;
#pragma unroll
            for (int ai = 0; ai < 2; ++ai)
#pragma unroll
                for (int m = 0; m < 4; ++m) {
                    const int row = pm * 256 + ai * 128 + wr * 64 + m * 16 + fr;
#pragma unroll
                    for (int bj = 0; bj < 2; ++bj) {
                        const f32x4 y0 = acc[ai][bj][m][0], y1 = acc[ai][bj][m][1];
                        u32x4 w; w.x = pk2(y0[0], y0[1]); w.y = pk2(y0[2], y0[3]); w.z = pk2(y1[0], y1[1]); w.w = pk2(y1[2], y1[3]);
                        *(u32x4*)(V + (size_t)row * 128 + hcol + 32 * bj + 8 * fq) = w;
                    }
                }
        } else {
            const bool isv = pn >= 5;
            bf16* dst = isv ? VG : U;
            const int cb = ((pn - (isv ? 5 : 3)) * 4 + wc) * 64;
#pragma unroll
            for (int ai = 0; ai < 2; ++ai)
#pragma unroll
                for (int m = 0; m < 4; ++m) {
                    const int row = pm * 256 + ai * 128 + wr * 64 + m * 16 + fr;
                    float s1 = 0.f, s2 = 0.f;
#pragma unroll
                    for (int bj = 0; bj < 2; ++bj) {
                        f32x4 y0 = acc[ai][bj][m][0], y1 = acc[ai][bj][m][1];
#pragma unroll
                        for (int j = 0; j < 4; ++j) { y0[j] = gelu_tanh(y0[j]); y1[j] = gelu_tanh(y1[j]); }
                        s1 += (y0[0] + y0[1]) + (y0[2] + y0[3]) + (y1[0] + y1[1]) + (y1[2] + y1[3]);
                        s2 += (y0[0] * y0[0] + y0[1] * y0[1]) + (y0[2] * y0[2] + y0[3] * y0[3]) + (y1[0] * y1[0] + y1[1] * y1[1]) + (y1[2] * y1[2] + y1[3] * y1[3]);
                        u32x4 w; w.x = pk2(y0[0], y0[1]); w.y = pk2(y0[2], y0[3]); w.z = pk2(y1[0], y1[1]); w.w = pk2(y1[2], y1[3]);
                        *(u32x4*)(dst + (size_t)row * 512 + cb + 32 * bj + 8 * fq) = w;
                    }
                    if (isv) {
                        s1 += __shfl_xor(s1, 16); s1 += __shfl_xor(s1, 32); s2 += __shfl_xor(s2, 16); s2 += __shfl_xor(s2, 32);
                        if (fq == 0) { float* sp = stats + (size_t)row * 16 + ((pn - 5) * 4 + wc) * 2; sp[0] = s1; sp[1] = s2; }
                    }
                }
        }
    }
};
struct EpiSwiglu {
    static constexpr bool PERM = true, AFTER_DRAIN = false;
    bf16* HID;
    __device__ __forceinline__ void operator()(const f32x4 (&acc)[2][2][4][2], const pg8::Unit& u, int wr, int wc, int fr, int fq) const {
#pragma unroll
        for (int ai = 0; ai < 2; ++ai)
#pragma unroll
            for (int m = 0; m < 4; ++m) {
                const int row = u.pm * 256 + ai * 128 + wr * 64 + m * 16 + fr;
                const f32x4 g0 = acc[ai][0][m][0], g1 = acc[ai][0][m][1], u0 = acc[ai][1][m][0], u1 = acc[ai][1][m][1];
                f32x4 y0, y1;
#pragma unroll
                for (int j = 0; j < 4; ++j) { y0[j] = silu_f(g0[j]) * u0[j]; y1[j] = silu_f(g1[j]) * u1[j]; }
                u32x4 w; w.x = pk2(y0[0], y0[1]); w.y = pk2(y0[2], y0[3]); w.z = pk2(y1[0], y1[1]); w.w = pk2(y1[2], y1[3]);
                *(u32x4*)(HID + (size_t)row * FFH + u.pn * 128 + wc * 32 + 8 * fq) = w;
            }
    }
};

struct RowOrder {
    pg8::StaticOrder b; int lat;
    __device__ __forceinline__ void init(int N, int G, int c, int latent_only) { lat = latent_only; b.init(latent_only ? NB * SEQ : M, N, G, c); }
    __device__ __forceinline__ bool next(int i, pg8::Unit& u) const { if (!b.next(i, u)) return false; if (lat) u.pm = u.pm + (u.pm >> 4) + 1; return true; }
    __device__ __forceinline__ void a_ready(const pg8::Unit&) const {}
    __device__ __forceinline__ void done(const pg8::Unit&) const {}
};

constexpr int CW_G3C = 3520;
struct G3Order {
    pg8::StaticOrder lat; int c; unsigned* cnt;
    __device__ __forceinline__ void init(int c_, unsigned* cnt_) { lat.init(NB * SEQ, FF2, 1, 0); c = c_; cnt = cnt_; }
    __device__ __forceinline__ bool next(int i, pg8::Unit& u) const {
        int idx;
        if (i < 10) idx = i * 256 + c;
        else { if (c < 32) return false; idx = 2560 + (c - 32) + (i - 10) * 224; if (idx >= 2992) return false; }
        if (idx < 176) { u.pm = 17 * (idx / 22); u.pn = idx % 22; }
        else { lat.next(idx - 176, u); u.pm = u.pm + (u.pm >> 4) + 1; }
        return true;
    }
    __device__ __forceinline__ void a_ready(const pg8::Unit&) const {}
    __device__ __forceinline__ void done(const pg8::Unit& u) const {
        if ((u.pm % 17) == 0) {
            __builtin_amdgcn_fence(__ATOMIC_RELEASE, "agent");
            asm volatile("s_waitcnt vmcnt(0)" ::: "memory");
            if ((threadIdx.x & 63) == 0) __hip_atomic_fetch_add(cnt, 1u, __ATOMIC_RELAXED, __HIP_MEMORY_SCOPE_AGENT);
        }
    }
};
struct CtxOneOrder {
    int c; unsigned* cnt; unsigned need;
    __device__ __forceinline__ bool next(int i, pg8::Unit& u) const { if (i != 0) return false; u.pm = 17 * (c >> 2); u.pn = c & 3; return true; }
    __device__ __forceinline__ void a_ready(const pg8::Unit&) const {
        unsigned sp = 0;
        while ((unsigned)__builtin_amdgcn_readfirstlane(__hip_atomic_load(cnt, __ATOMIC_RELAXED, __HIP_MEMORY_SCOPE_AGENT)) < need) { __builtin_amdgcn_s_sleep(4); if (++sp > (1u << 22)) break; }
        __builtin_amdgcn_fence(__ATOMIC_ACQUIRE, "agent");
        asm volatile("s_waitcnt vmcnt(0)" ::: "memory");
    }
    __device__ __forceinline__ void done(const pg8::Unit&) const {}
};

namespace att {
constexpr int D = 64, QBLK = 32, KVBLK = 64;
constexpr float SCALE = 0.125f, THR = 8.f;
constexpr int SHM_T = KVBLK * D * 2;
constexpr int NSLOT = 4, OFF_V = 0, OFF_K = NSLOT * SHM_T, OFF_WS = 2 * NSLOT * SHM_T, OFF_OST = OFF_WS + NWAVES * 64 * 4, SHM_ATTN = OFF_OST + NWAVES * 4096;
#define SBAR() __builtin_amdgcn_sched_barrier(0)
#define KSWZ(s, colB) ((s) * 256 + ((colB) ^ (((s) & 15) << 4)))
__device__ __forceinline__ int crow(int r, int hi) { return (r & 3) + 8 * (r >> 2) + 4 * hi; }
__device__ __forceinline__ unsigned cvtpk(float lo, float hi) { unsigned r; asm volatile("v_cvt_pk_bf16_f32 %0, %1, %2" : "=v"(r) : "v"(lo), "v"(hi)); return r; }

__device__ __forceinline__ void partialSM(f32x16& p0) {
#pragma unroll
    for (int r = 0; r < 16; ++r) p0[r] = __builtin_amdgcn_exp2f(p0[r]);
}
__device__ __forceinline__ void finishSM(f32x16& p0, f32x16& p1, float& l_reg, bf16x8& pa0, bf16x8& pa1, bf16x8& pa2, bf16x8& pa3) {
#pragma unroll
    for (int r = 0; r < 16; ++r) p1[r] = __builtin_amdgcn_exp2f(p1[r]);
    float ps = p0[0];
#pragma unroll
    for (int r = 1; r < 16; ++r) ps += p0[r];
#pragma unroll
    for (int r = 0; r < 16; ++r) ps += p1[r];
    l_reg += ps;
#define PK4(P, BASE, OUT) do { unsigned a0 = cvtpk(P[BASE + 0], P[BASE + 1]), a1 = cvtpk(P[BASE + 2], P[BASE + 3]);   \
    unsigned b0 = cvtpk(P[BASE + 4], P[BASE + 5]), b1 = cvtpk(P[BASE + 6], P[BASE + 7]);                              \
    u32x4 w = {a0, a1, b0, b1}; OUT = *reinterpret_cast<bf16x8*>(&w); } while (0)
    PK4(p0, 0, pa0); PK4(p0, 8, pa1); PK4(p1, 0, pa2); PK4(p1, 8, pa3);
#undef PK4
}
__device__ __forceinline__ void qkt(f32x16& p0, f32x16& p1, const char* Ks, const bf16x8* qr, const f32x16& negm, int r32, int hi) {
#pragma unroll
    for (int d0 = 0; d0 < 4; ++d0) { const int cb = (d0 * 16 + hi * 8) * 2;
        const bf16x8 b0 = *reinterpret_cast<const bf16x8*>(Ks + KSWZ(r32, cb));
        const bf16x8 b1 = *reinterpret_cast<const bf16x8*>(Ks + KSWZ(r32, 128 + cb));
        if (d0 == 0) { p0 = __builtin_amdgcn_mfma_f32_32x32x16_bf16(b0, qr[0], negm, 0, 0, 0); p1 = __builtin_amdgcn_mfma_f32_32x32x16_bf16(b1, qr[0], negm, 0, 0, 0); }
        else { p0 = __builtin_amdgcn_mfma_f32_32x32x16_bf16(b0, qr[d0], p0, 0, 0, 0); p1 = __builtin_amdgcn_mfma_f32_32x32x16_bf16(b1, qr[d0], p1, 0, 0, 0); } }
}
__device__ __forceinline__ int v_st(int k, int c) { const int kk = (k & ~0xC) | ((k & 4) << 1) | ((k & 8) >> 1); return ((kk >> 3) * 2 + (c >> 5)) * 512 + ((kk & 7) * 32 + (c & 31)) * 2; }
__device__ __forceinline__ int v_rd_base(int lane) { return (((lane & 3) << 3) | (((lane >> 2) & 3) << 6) | (((lane >> 4) & 1) << 5)) + ((lane >> 5) & 1) * 1024; }
constexpr int v_rd_off(int d0, int ks, int half) { return d0 * 512 + ks * 2048 + half * 256; }
typedef short v4i16_t __attribute__((ext_vector_type(4)));
template <int OFF> __device__ __forceinline__ s16x4 tr_read(int vb) {
    return __builtin_bit_cast(s16x4, __builtin_amdgcn_ds_read_tr16_b64_v4i16((LAS v4i16_t*)(unsigned)(vb + OFF)));
}
template <int D0> __device__ __forceinline__ void pv_one(f32x16& od, int vb, bf16x8 pa0, bf16x8 pa1, bf16x8 pa2, bf16x8 pa3) {
    const s16x4 l0 = tr_read<v_rd_off(D0, 0, 0)>(vb), h0 = tr_read<v_rd_off(D0, 0, 1)>(vb), l1 = tr_read<v_rd_off(D0, 1, 0)>(vb), h1 = tr_read<v_rd_off(D0, 1, 1)>(vb);
    const s16x4 l2 = tr_read<v_rd_off(D0, 2, 0)>(vb), h2 = tr_read<v_rd_off(D0, 2, 1)>(vb), l3 = tr_read<v_rd_off(D0, 3, 0)>(vb), h3 = tr_read<v_rd_off(D0, 3, 1)>(vb);
#define PK(L, H) (bf16x8){L[0], L[1], L[2], L[3], H[0], H[1], H[2], H[3]}
    od = __builtin_amdgcn_mfma_f32_32x32x16_bf16(pa0, PK(l0, h0), od, 0, 0, 0);
    od = __builtin_amdgcn_mfma_f32_32x32x16_bf16(pa1, PK(l1, h1), od, 0, 0, 0);
    od = __builtin_amdgcn_mfma_f32_32x32x16_bf16(pa2, PK(l2, h2), od, 0, 0, 0);
    od = __builtin_amdgcn_mfma_f32_32x32x16_bf16(pa3, PK(l3, h3), od, 0, 0, 0);
#undef PK
}
__device__ __forceinline__ void pv_d0(f32x16* o, int vb, bf16x8 pa0, bf16x8 pa1, bf16x8 pa2, bf16x8 pa3) {
    pv_one<0>(o[0], vb, pa0, pa1, pa2, pa3); pv_one<1>(o[1], vb, pa0, pa1, pa2, pa3);
}
constexpr int LDQ = 512, LDK = 128, LDO = 1024;
__device__ __forceinline__ void attn_body(const bf16* __restrict__ Qb, const bf16* __restrict__ Kh, const bf16* __restrict__ Vh, bf16* __restrict__ Ob, int seq, float m0l2, char* lds, bool pre, bool post) {
    const int tid = tid_fresh(), wid = tid >> 6, lane = tid & 63, r32 = lane & 31, hi = lane >> 5;
    char* V_lds = lds + OFF_V; char* K_lds = lds + OFF_K;
    float* li_l = (float*)(lds + OFF_WS) + wid * 64;
    float l_reg = 0; f32x16 o[2] = {}; bf16x8 qr[4];
    f32x16 negm;
#pragma unroll
    for (int r = 0; r < 16; ++r) negm[r] = -m0l2;
    asm volatile("" : "+v"(negm));
    const bf16* Qw = Qb + (long)(wid * QBLK + r32) * LDQ + hi * 8;
#pragma unroll
    for (int d0 = 0; d0 < 4; ++d0) qr[d0] = __builtin_nontemporal_load(reinterpret_cast<const bf16x8*>(Qw + d0 * 16));
    const int wsg = __builtin_amdgcn_readfirstlane(wid);
    const int oo = (wsg * 64 + lane) * 16;
    const int ksr = oo >> 8, kcolB = (oo & 255) ^ ((ksr & 15) << 4);
    const bf16* kptr = Kh + (long)(ksr + 32 * (kcolB >> 7)) * LDK + ((kcolB & 127) >> 1);
    const int vkk = ((oo >> 9) >> 1) * 8 + ((oo & 511) >> 6), vcc = ((oo >> 9) & 1) * 32 + ((oo & 63) >> 1);
    const bf16* vptr = Vh + (long)((vkk & ~0xC) | ((vkk & 4) << 1) | ((vkk & 8) >> 1)) * LDK + vcc;
    LAS unsigned char* const ldsK = (LAS unsigned char*)lds + OFF_K + wsg * 1024; LAS unsigned char* const ldsV = (LAS unsigned char*)lds + OFF_V + wsg * 1024;
    const int vb0 = (int)(uintptr_t)V_lds + v_rd_base(lane);
    const int NT = seq / KVBLK;
#define SLOT(t) (((t) & 3) << 13)
#define DMA(t) do { const int t_ = (t) < NT ? (t) : NT - 1; const long off_ = (long)t_ * (KVBLK * LDK); \
        __builtin_amdgcn_global_load_lds((const unsigned*)(kptr + off_), (LAS unsigned*)(ldsK + SLOT(t)), 16, 0, 0); \
        __builtin_amdgcn_global_load_lds((const unsigned*)(vptr + off_), (LAS unsigned*)(ldsV + SLOT(t)), 16, 0, 0); } while (0)
#define WBAR(N) asm volatile("s_waitcnt vmcnt(" #N ") lgkmcnt(0)\n\ts_barrier" ::: "memory")
    f32x16 pA0, pA1, pB0, pB1; bf16x8 pa0, pa1, pa2, pa3;
#define HALF(PX0, PX1, PY0, PY1, j_, MORE) do { \
        SBAR(); if (MORE) DMA((j_) + 2); qkt(PX0, PX1, K_lds + SLOT(j_), qr, negm, r32, hi); \
        finishSM(PY0, PY1, l_reg, pa0, pa1, pa2, pa3); \
        pv_d0(o, vb0 + SLOT((j_) - 1), pa0, pa1, pa2, pa3); partialSM(PX0); \
        if (MORE) WBAR(2); else WBAR(0); } while (0)
    if (!pre) { DMA(0); DMA(1); } DMA(2); WBAR(2);
    qkt(pA0, pA1, K_lds, qr, negm, r32, hi); partialSM(pA0);
    int j = 1;
    for (; j + 4 < NT; j += 2) {
        HALF(pB0, pB1, pA0, pA1, j, true);
        HALF(pA0, pA1, pB0, pB1, j + 1, true);
    }
    HALF(pB0, pB1, pA0, pA1, j, true);
    HALF(pA0, pA1, pB0, pB1, j + 1, false);
    if (post) { DMA(0); DMA(1); }
    SBAR(); qkt(pB0, pB1, K_lds + SLOT(NT - 1), qr, negm, r32, hi);
    finishSM(pA0, pA1, l_reg, pa0, pa1, pa2, pa3); SBAR();
    pv_d0(o, vb0 + SLOT(NT - 2), pa0, pa1, pa2, pa3); partialSM(pB0);
    finishSM(pB0, pB1, l_reg, pa0, pa1, pa2, pa3); SBAR();
    pv_d0(o, vb0 + SLOT(NT - 1), pa0, pa1, pa2, pa3);
    { auto rr = __builtin_amdgcn_permlane32_swap(__float_as_uint(l_reg), __float_as_uint(l_reg), false, false); l_reg = __uint_as_float(rr[0]) + __uint_as_float(rr[1]); }
    if (hi == 0) li_l[r32] = l_reg; asm volatile("s_waitcnt lgkmcnt(0)" ::: "memory");
    float rli[16];
#pragma unroll
    for (int r = 0; r < 16; ++r) rli[r] = __builtin_amdgcn_rcpf(li_l[crow(r, hi)]);
    bf16* Ow = Ob + (long)(wid * QBLK) * LDO;
    {
        bf16* stg = (bf16*)(lds + OFF_OST) + wid * 2048;
#pragma unroll
        for (int r = 0; r < 16; ++r) { const int orow = crow(r, hi);
#pragma unroll
            for (int d0 = 0; d0 < 2; ++d0) stg[orow * 64 + d0 * 32 + r32] = (bf16)f2bf(o[d0][r] * rli[r]); }
        asm volatile("s_waitcnt lgkmcnt(0)" ::: "memory");
#pragma unroll
        for (int i = 0; i < 4; ++i) { const int row = i * 8 + (lane >> 3), ch = lane & 7; const u32x4 v = *(const u32x4*)(stg + row * 64 + ch * 8); *(u32x4*)(Ow + (long)row * LDO + ch * 8) = v; }
    }
    asm volatile("s_waitcnt vmcnt(0)" ::: "memory");
    __syncthreads();
#undef HALF
#undef DMA
#undef WBAR
#undef SLOT
}
#undef SBAR
}

constexpr int GT_PITCH = 136;
struct GateRegs { u32x4 v0, v1; f32x4 sa, sb, sc, sd; u32x2 uu[4]; bf16x8 wf[8]; };
__device__ __forceinline__ void gate_phase(int bx, int G, bool skip_ctx, const bf16* __restrict__ VG, const bf16* __restrict__ U, const float* __restrict__ stats,
                                           const float* __restrict__ gsg, const float* __restrict__ bsg, const bf16* __restrict__ Wl, const float* __restrict__ bsl,
                                           bf16* __restrict__ MIX, char* lds) {
    const int tid = tid_fresh(), wid = tid >> 6, lane = tid & 63, r32 = lane & 31, hi = lane >> 5;
    bf16* T = (bf16*)lds;
    const int q = tid >> 2, dc = (tid & 3) * 16;
    const int db = wid & 1, pb = wid >> 1, p = pb * 32 + r32;
    const int NU = (M / 128) * 8;
    auto unit_ok = [&](int u) { return u < NU && !(skip_ctx && ((u >> 3) % 34) < 2); };
    auto next_unit = [&](int u) { u += G; while (u < NU && !unit_ok(u)) u += G; return u; };
    int u = bx; if (!unit_ok(u)) u = next_unit(u);
    GateRegs R;
#define GATE_LOAD(uu_) do { const int chunk_ = (uu_) >> 3, h_ = (uu_) & 7; const size_t rq = (size_t)chunk_ * 128 + q; \
        const float* st_ = stats + rq * 16; R.sa = *(const f32x4*)st_; R.sb = *(const f32x4*)(st_ + 4); R.sc = *(const f32x4*)(st_ + 8); R.sd = *(const f32x4*)(st_ + 12); \
        R.v0 = __builtin_nontemporal_load((const u32x4*)(VG + rq * 512 + h_ * 64 + dc)); R.v1 = __builtin_nontemporal_load((const u32x4*)(VG + rq * 512 + h_ * 64 + dc + 8)); \
        const size_t rp = (size_t)chunk_ * 128 + p; \
        _Pragma("unroll") for (int g4 = 0; g4 < 4; ++g4) R.uu[g4] = __builtin_nontemporal_load((const u32x2*)(U + rp * 512 + h_ * 64 + db * 32 + 8 * g4 + 4 * hi)); \
        const bf16* wrow_ = Wl + ((size_t)h_ * 128 + p) * 128 + hi * 8; \
        _Pragma("unroll") for (int ks = 0; ks < 8; ++ks) R.wf[ks] = *(const bf16x8*)(wrow_ + ks * 16); } while (0)
    if (u < NU) GATE_LOAD(u);
    while (u < NU) {
        const int chunk = u >> 3, h = u & 7;
        {
            const float s1 = (R.sa[0] + R.sa[2]) + (R.sb[0] + R.sb[2]) + (R.sc[0] + R.sc[2]) + (R.sd[0] + R.sd[2]);
            const float s2 = (R.sa[1] + R.sa[3]) + (R.sb[1] + R.sb[3]) + (R.sc[1] + R.sc[3]) + (R.sd[1] + R.sd[3]);
            const float mean = s1 * (1.0f / 512.0f);
            const float var = fmaxf(s2 * (1.0f / 512.0f) - mean * mean, 0.f);
            const float rstd = __builtin_amdgcn_rsqf(var + EPS);
            const float* gp = gsg + h * 64 + dc; const float* bp = bsg + h * 64 + dc;
#pragma unroll
            for (int i = 0; i < 8; ++i) {
                const unsigned w = i < 4 ? R.v0[i] : R.v1[i - 4];
                const float x0 = (bflo(w) - mean) * rstd * gp[2 * i] + bp[2 * i], x1 = (bfhi(w) - mean) * rstd * gp[2 * i + 1] + bp[2 * i + 1];
                T[(dc + 2 * i) * GT_PITCH + q] = (bf16)f2bf(x0); T[(dc + 2 * i + 1) * GT_PITCH + q] = (bf16)f2bf(x1);
            }
        }
        u32x2 ucur[4]; bf16x8 wcur[8];
#pragma unroll
        for (int g4 = 0; g4 < 4; ++g4) ucur[g4] = R.uu[g4];
#pragma unroll
        for (int ks = 0; ks < 8; ++ks) wcur[ks] = R.wf[ks];
        const float bias = bsl[h * 128 + p];
        const int un = next_unit(u);
        if (un < NU) GATE_LOAD(un);
        __syncthreads();
        f32x16 acc = {};
        const bf16* trow = T + (db * 32 + r32) * GT_PITCH + hi * 8;
#pragma unroll
        for (int ks = 0; ks < 8; ++ks) {
            const bf16x8 av = *(const bf16x8*)(trow + ks * 16);
            acc = __builtin_amdgcn_mfma_f32_32x32x16_bf16(av, wcur[ks], acc, 0, 0, 0);
        }
        const size_t row = (size_t)chunk * 128 + p;
#pragma unroll
        for (int g4 = 0; g4 < 4; ++g4) {
            const int d0 = db * 32 + 8 * g4 + 4 * hi;
            u32x2 w;
            w.x = pk2(bflo(ucur[g4].x) * (acc[4 * g4 + 0] + bias), bfhi(ucur[g4].x) * (acc[4 * g4 + 1] + bias));
            w.y = pk2(bflo(ucur[g4].y) * (acc[4 * g4 + 2] + bias), bfhi(ucur[g4].y) * (acc[4 * g4 + 3] + bias));
            *(u32x2*)(MIX + row * 1024 + 512 + h * 64 + d0) = w;
        }
        __syncthreads();
        u = un;
    }
#undef GATE_LOAD
}

struct RowPass { const float* x_in; const float* ctx_in; float* out; float* xc; const bf16* Y; bf16* H; const float* mod;
                 const float* gpost; const float* gpre; int init, update, norm_out, lg, gi, ln, si, skip_ctx; };
__device__ __forceinline__ void row_pass(const RowPass& R, int gw, int ngw, int lane) {
    constexpr int NR = 2;
    for (int row0 = gw; row0 < M; row0 += NR * ngw) {
        f32x4 v[NR][4]; u32x2 yw[NR][4]; bool act[NR]; float* xrow[NR]; int bbs[NR];
#pragma unroll
        for (int k = 0; k < NR; ++k) {
            const int row = row0 + k * ngw;
            const int rowc = row < M ? row : row0;
            const int b = rowc / RPB, i = rowc - b * RPB; const bool isctx = i < CTXL;
            act[k] = (row < M) && !(isctx && R.skip_ctx);
            bbs[k] = isctx ? 8 : b;
            xrow[k] = isctx ? R.xc + ((size_t)b * CTXL + i) * DM : R.out + ((size_t)b * SEQ + (i - CTXL)) * DM;
            const float* src = R.init ? (isctx ? R.ctx_in + ((size_t)b * CTXL + i) * DM : R.x_in + ((size_t)b * SEQ + (i - CTXL)) * DM) : xrow[k];
            if (act[k]) {
#pragma unroll
                for (int j = 0; j < 4; ++j) v[k][j] = __builtin_nontemporal_load((const f32x4*)(src + lane * 4 + 256 * j));
                if (R.update) { const bf16* yr = R.Y + (size_t)rowc * DM;
#pragma unroll
                    for (int j = 0; j < 4; ++j) yw[k][j] = __builtin_nontemporal_load((const u32x2*)(yr + lane * 4 + 256 * j)); }
            }
        }
#pragma unroll
        for (int k = 0; k < NR; ++k) {
            if (!act[k]) continue;
            const int row = row0 + k * ngw, bb = bbs[k];
            if (R.update) {
                f32x4 y[4]; float ss = 0.f;
#pragma unroll
                for (int j = 0; j < 4; ++j) { const u32x2 w = yw[k][j]; y[j] = (f32x4){bflo(w.x), bfhi(w.x), bflo(w.y), bfhi(w.y)};
                    ss += (y[j][0] * y[j][0] + y[j][1] * y[j][1]) + (y[j][2] * y[j][2] + y[j][3] * y[j][3]); }
                const float rstd = __builtin_amdgcn_rsqf(wave_sum(ss) * (1.0f / DM) + EPS);
                const float* gate = R.mod + ((size_t)(R.lg * 9 + bb) * NMOD + R.gi) * DM;
#pragma unroll
                for (int j = 0; j < 4; ++j) { const f32x4 g = *(const f32x4*)(gate + lane * 4 + 256 * j), gp = *(const f32x4*)(R.gpost + lane * 4 + 256 * j);
                    v[k][j] = v[k][j] + g * (y[j] * rstd * gp); }
            }
            if (R.init || R.update) {
#pragma unroll
                for (int j = 0; j < 4; ++j) __builtin_nontemporal_store(v[k][j], (f32x4*)(xrow[k] + lane * 4 + 256 * j));
            }
            if (R.norm_out) {
                float ss = 0.f;
#pragma unroll
                for (int j = 0; j < 4; ++j) ss += (v[k][j][0] * v[k][j][0] + v[k][j][1] * v[k][j][1]) + (v[k][j][2] * v[k][j][2] + v[k][j][3] * v[k][j][3]);
                const float rstd = __builtin_amdgcn_rsqf(wave_sum(ss) * (1.0f / DM) + EPS);
                const float* shift = R.mod + ((size_t)(R.ln * 9 + bb) * NMOD + R.si) * DM; const float* scale = shift + DM;
                bf16* hr = R.H + (size_t)row * DM;
#pragma unroll
                for (int j = 0; j < 4; ++j) { const f32x4 gp = *(const f32x4*)(R.gpre + lane * 4 + 256 * j), sh = *(const f32x4*)(shift + lane * 4 + 256 * j), sc = *(const f32x4*)(scale + lane * 4 + 256 * j);
                    const f32x4 hv = (v[k][j] * rstd * gp) * (sc + 1.0f) + sh;
                    u32x2 w; w.x = pk2(hv[0], hv[1]); w.y = pk2(hv[2], hv[3]); *(u32x2*)(hr + lane * 4 + 256 * j) = w; }
            }
        }
    }
}

__device__ __forceinline__ int rowmap(int mode, int n0) {
    if (mode == 1) { const int pn = n0 >> 8, q = n0 & 255; return pn * 256 + 128 * ((q & 63) >> 5) + 32 * (q >> 6); }
    if (mode == 2) { const int bj = n0 >= FFH ? 1 : 0, r = n0 - bj * FFH; return (r >> 7) * 256 + bj * 128 + (r & 127); }
    return n0;
}
__device__ __forceinline__ void transpose_item(const float* __restrict__ W, int K, int N, bf16* __restrict__ WT, int mode, LAS float* scr, int item, int lane) {
    const int nblk = N / 32, kb = item / nblk, nb = item % nblk, k0 = 64 * kb, n0 = 32 * nb;
#pragma unroll 8
    for (int i = 0; i < 32; ++i) { const int kk = 2 * i + (lane >> 5); scr[kk * 33 + (lane & 31)] = __builtin_nontemporal_load(W + (size_t)(k0 + kk) * N + n0 + (lane & 31)); }
    asm volatile("s_waitcnt lgkmcnt(0)" ::: "memory");
    const int c = lane & 7; const int r0 = rowmap(mode, n0);
#pragma unroll
    for (int j = 0; j < 4; ++j) { const int n = (lane >> 3) + 8 * j; const LAS float* s = scr + (8 * c) * 33 + n;
        u32x4 o; o.x = pk2(s[0 * 33], s[1 * 33]); o.y = pk2(s[2 * 33], s[3 * 33]); o.z = pk2(s[4 * 33], s[5 * 33]); o.w = pk2(s[6 * 33], s[7 * 33]);
        *(u32x4*)(WT + (size_t)(r0 + n) * K + k0 + 8 * c) = o; }
    asm volatile("s_waitcnt lgkmcnt(0)" ::: "memory");
}

__device__ __forceinline__ void convert_weights(ArgP A, unsigned char* lds_g, int gw, int NGW, int l0, int l1, int lane, int wave) {
    unsigned char* ws = A->ws;
    LAS float* scr = (LAS float*)((LAS unsigned char*)lds_g + wave * 8704);
    constexpr int I_IN = (DM / 64) * (INW / 32), I_OUT = (DM / 64) * (DM / 32), I_F1 = (DM / 64) * (FF2 / 32), I_F2 = (FFH / 64) * (DM / 32);
    constexpr int PER_L = I_IN + I_OUT + I_F1 + I_F2;
    for (int it = l0 * PER_L + gw; it < l1 * PER_L; it += NGW) {
        const int l = it / PER_L; int r = it - l * PER_L;
        if (r < I_IN) { transpose_item(A->w_in + (size_t)l * DM * INW, DM, INW, (bf16*)(ws + WS_WIN) + (size_t)l * INW * DM, 1, scr, r, lane); continue; } r -= I_IN;
        if (r < I_OUT) { transpose_item(A->w_out + (size_t)l * DM * DM, DM, DM, (bf16*)(ws + WS_WOUT) + (size_t)l * DM * DM, 0, scr, r, lane); continue; } r -= I_OUT;
        if (r < I_F1) { transpose_item(A->w_ffn_in + (size_t)l * DM * FF2, DM, FF2, (bf16*)(ws + WS_WF1) + (size_t)l * FF2 * DM, 2, scr, r, lane); continue; } r -= I_F1;
        transpose_item(A->w_ffn_out + (size_t)l * FFH * DM, FFH, DM, (bf16*)(ws + WS_WF2) + (size_t)l * DM * FFH, 0, scr, r, lane);
    }
}
__device__ __forceinline__ void prologue(ArgP A, unsigned char* lds_g, int vcu, int G) {
    const int tid = tid_fresh(), lane = tid & 63, wave = tid >> 6;
    unsigned char* ws = A->ws;
    convert_weights(A, lds_g, vcu * NWAVES + wave, G * NWAVES, 0, G == 256 ? 1 : DEPTH, lane, wave);
    {
        const int gt = vcu * NTHR + tid, NGT = G * NTHR;
        const int n4 = DEPTH * 8 * 128 * 128 / 4;
        bf16* wsb = (bf16*)(ws + WS_WS);
        for (int i = gt; i < n4; i += NGT) { const f32x4 v = *(const f32x4*)(A->w_s + (size_t)i * 4); u32x2 w; w.x = pk2(v[0], v[1]); w.y = pk2(v[2], v[3]); *(u32x2*)(wsb + (size_t)i * 4) = w; }
        if (gt < 1024) { const int pos = gt >> 4, f = gt & 15; const float inv = __builtin_amdgcn_exp2f(-(float)f * (13.287712379549449f / 16.0f)); const float ang = (float)pos * inv;
            float* rc = (float*)(ws + WS_ROPE); rc[gt] = __cosf(ang); rc[1024 + gt] = __sinf(ang); }
    }
    __syncthreads();
    {
        float* sil = (float*)lds_g;
        float* red = (float*)lds_g + 9 * 1024;
        for (int i = tid; i < 9 * 1024; i += NTHR) { const float cv = i < 8 * 1024 ? A->c[i] : A->c_ctx[i - 8 * 1024]; sil[i] = cv / (1.0f + __expf(-cv)); }
        __syncthreads();
        const int kg = tid >> 6, n = tid & 63;
        constexpr int NU = DEPTH * (NMOD * DM / 64);
        for (int un = vcu; un < NU; un += G) {
            const int l = un / (NMOD * DM / 64), cb = (un % (NMOD * DM / 64)) * 64;
            const float* wp = A->w_mod + ((size_t)l * DM + kg * 128) * (NMOD * DM) + cb + n;
            float acc[9];
#pragma unroll
            for (int bb = 0; bb < 9; ++bb) acc[bb] = 0.f;
#pragma unroll 2
            for (int k = 0; k < 128; k += 4) {
                const float w0 = __builtin_nontemporal_load(wp + (size_t)(k + 0) * (NMOD * DM)), w1 = __builtin_nontemporal_load(wp + (size_t)(k + 1) * (NMOD * DM)), w2 = __builtin_nontemporal_load(wp + (size_t)(k + 2) * (NMOD * DM)), w3 = __builtin_nontemporal_load(wp + (size_t)(k + 3) * (NMOD * DM));
#pragma unroll
                for (int bb = 0; bb < 9; ++bb) { const f32x4 s = *(const f32x4*)(sil + bb * 1024 + kg * 128 + k); acc[bb] += (s[0] * w0 + s[1] * w1) + (s[2] * w2 + s[3] * w3); }
            }
#pragma unroll
            for (int bb = 0; bb < 9; ++bb) red[(kg * 9 + bb) * 64 + n] = acc[bb];
            __syncthreads();
            for (int o = tid; o < 9 * 64; o += NTHR) { const int bb = o >> 6, nn = o & 63; float s = 0.f;
#pragma unroll
                for (int g = 0; g < 8; ++g) s += red[(g * 9 + bb) * 64 + nn];
                ((float*)(ws + WS_MOD))[((size_t)(l * 9 + bb)) * (NMOD * DM) + cb + nn] = s + A->b_mod[(size_t)l * NMOD * DM + cb + nn]; }
            __syncthreads();
        }
    }
}

constexpr int N_PHASES = 2 + 7 * DEPTH;
__global__ void __launch_bounds__(NTHR, 2) fwd_kernel(Args A_) {
    extern __shared__ __attribute__((aligned(16))) unsigned char lds[];
    cg::grid_group grid = cg::this_grid();
    const int G = gridDim.x, bx = blockIdx.x;
    volatile LAS unsigned* MISC = (volatile LAS unsigned*)((LAS unsigned char*)lds + LDS_STAGE);
    if (threadIdx.x < 8) MISC[threadIdx.x] = 0u;
    __syncthreads();
    (void)xcd_barrier_post((unsigned*)(A_.ws + WS_BAR), MISC);
    const int vcu = (G % 8 == 0) ? (bx % 8) * (G / 8) + bx / 8 : bx;
#ifndef PROBE_DUP
#define PROBE_DUP 0
#endif
#pragma unroll 1
    for (int st = A_.ph_lo * 2; st < A_.ph_hi * 2; ++st) {
        const int ph = st >> 1;
        ArgP A = (ArgP)__builtin_amdgcn_kernarg_segment_ptr(); asm volatile("" : "+s"(A));
        {
            const int ptype = ph == 0 ? 0 : ph == 1 ? 7 : 1 + (ph - 2) % 7;
            if ((st & 1) && !((PROBE_DUP >> ptype) & 1) && !((PROBE_DUP >> 8) & 1)) continue;
        }
        const int tid = tid_fresh(), lane = tid & 63, wave = __builtin_amdgcn_readfirstlane(tid >> 6);
        const int gw = vcu * NWAVES + wave, ngw = G * NWAVES;
        unsigned char* const ws = A->ws;
        bf16* const Hb = (bf16*)(ws + WS_H); bf16* const Yb = (bf16*)(ws + WS_Y); bf16* const HIDb = (bf16*)(ws + WS_BIG);
        bf16* const Qb = (bf16*)(ws + WS_Q); bf16* const Kb = (bf16*)(ws + WS_K); bf16* const Vb = (bf16*)(ws + WS_V); bf16* const Ub = (bf16*)(ws + WS_U); bf16* const VGb = (bf16*)(ws + WS_VG); bf16* const MIXb = (bf16*)(ws + WS_MIX);
        float* const modp = (float*)(ws + WS_MOD); float* const statp = (float*)(ws + WS_STATS); float* const xc = (float*)(ws + WS_XC);
        if ((st & 1) && ((PROBE_DUP >> 8) & 1)) {
        } else
        if (ph == 0) {
            prologue(A, lds, vcu, G);
        } else if (ph == 1) {
            RowPass R{A->x, A->ctx, A->out, xc, nullptr, Hb, modp, nullptr, A->g_pre_mix, 1, 0, 1, 0, 0, 0, 0, 0};
            row_pass(R, gw, ngw, lane);
        } else {
            const int l = (ph - 2) / 7, s = (ph - 2) % 7;
            if (s == 0) {
                pg8::Gemm g{Hb, (const bf16*)(ws + WS_WIN) + (size_t)l * INW * DM, M, INW, DM}; RowOrder S; S.init(INW, G, bx, 0);
                EpiInProj E{ws, A->g_q + l * 64, A->g_k + l * 64};
                pg8::gemm_phase<EpiInProj, RowOrder, true, true>((LAS unsigned char*)lds, g, S, E);
            } else if (s == 1) {
                const bool lastl = (l == DEPTH - 1);
                float gqm = fabsf(A->g_q[l * 64 + lane]), gkm = fabsf(A->g_k[l * 64 + lane]);
#pragma unroll
                for (int o = 1; o < 64; o <<= 1) { gqm = fmaxf(gqm, __shfl_xor(gqm, o)); gkm = fmaxf(gkm, __shfl_xor(gkm, o)); }
                const float m0l2 = 8.0f * 1.4426950408889634f * gqm * gkm;
                const bool chain = (G == 256);
                const bool hasctx = bx < 64 && !lastl;
                for (int i = 0; ; ++i) {
                    const int u = bx + i * G; if (u >= NB * 16 * 8) break;
                    const int b = u & 7, rest = u >> 3, h = rest & 7, qb = rest >> 3;
                    const size_t r0 = (size_t)b * RPB;
                    const bool more = (u + G < NB * 16 * 8) || hasctx;
                    att::attn_body(Qb + (r0 + CTXL + qb * 256) * 512 + h * 64, Kb + r0 * 128 + (h >> 2) * 64, Vb + r0 * 128 + (h >> 2) * 64,
                                   MIXb + (r0 + CTXL + qb * 256) * 1024 + h * 64, RPB, m0l2, (char*)lds, chain && i > 0, chain && more);
                }
                if (hasctx) {
                    const int b = bx & 7, h = bx >> 3; const size_t r0 = (size_t)b * RPB;
                    att::attn_body(Qb + r0 * 512 + h * 64, Kb + r0 * 128 + (h >> 2) * 64, Vb + r0 * 128 + (h >> 2) * 64, MIXb + r0 * 1024 + h * 64, CTXL, m0l2, (char*)lds, chain, false);
                }
                for (int grep_ = 0; grep_ < (((PROBE_DUP >> 9) & 1) ? 2 : 1); ++grep_)
                    gate_phase(bx, G, lastl, VGb, Ub, statp, A->g_sg + l * 512, A->b_sg + l * 512, (const bf16*)(ws + WS_WS) + (size_t)l * 8 * 128 * 128, A->b_s + l * 8 * 128, MIXb, (char*)lds);
            } else if (s == 2 || s == 5) {
                pg8::Gemm g = (s == 2) ? pg8::Gemm{MIXb, (const bf16*)(ws + WS_WOUT) + (size_t)l * DM * DM, M, DM, DM}
                                       : pg8::Gemm{HIDb, (const bf16*)(ws + WS_WF2) + (size_t)l * DM * FFH, M, DM, FFH};
                RowOrder S; S.init(DM, G, bx, (l == DEPTH - 1) || (s == 5 && G == 256));
                pg8::EpiBf16<0> E{Yb, DM, nullptr, 0, 0, 1.f};
                pg8::gemm_phase<pg8::EpiBf16<0>, RowOrder, true, true>((LAS unsigned char*)lds, g, S, E);
                if (s == 2 && G == 256 && l + 1 < DEPTH && bx >= 32)
                    convert_weights(A, lds, (bx - 32) * NWAVES + wave, (G - 32) * NWAVES, l + 1, l + 2, lane, wave);
            } else if (s == 3) {
                RowPass R{A->x, A->ctx, A->out, xc, Yb, Hb, modp, A->g_post_mix + l * DM, A->g_pre_ffn + l * DM, 0, 1, 1, l, 2, l, 3, l == DEPTH - 1};
                row_pass(R, gw, ngw, lane);
                if ((PROBE_DUP >> 10) & 1) { RowPass R2{A->x, A->ctx, A->out, xc, Yb, Hb, modp, A->g_post_mix + l * DM, A->g_pre_ffn + l * DM, 0, 0, 1, l, 2, l, 3, l == DEPTH - 1}; row_pass(R2, gw, ngw, lane); }
            } else if (s == 4) {
                pg8::Gemm g{Hb, (const bf16*)(ws + WS_WF1) + (size_t)l * FF2 * DM, M, FF2, DM};
                EpiSwiglu E{HIDb};
                if (l == DEPTH - 1 || G != 256) {
                    RowOrder S; S.init(FF2, G, bx, l == DEPTH - 1);
                    pg8::gemm_phase<EpiSwiglu, RowOrder, true, true>((LAS unsigned char*)lds, g, S, E);
                } else {
                    unsigned* cnt = (unsigned*)(ws + WS_BAR) + CW_G3C + 64 * l;
                    G3Order S; S.init(bx, cnt);
                    pg8::gemm_phase<EpiSwiglu, G3Order, true, true>((LAS unsigned char*)lds, g, S, E);
                    if (bx < 32) {
                        pg8::Gemm g2{HIDb, (const bf16*)(ws + WS_WF2) + (size_t)l * DM * FFH, M, DM, FFH};
                        CtxOneOrder S2{bx, cnt, 176u * 8u};
                        pg8::EpiBf16<0> E2{Yb, DM, nullptr, 0, 0, 1.f};
                        pg8::gemm_phase<pg8::EpiBf16<0>, CtxOneOrder, true, true>((LAS unsigned char*)lds, g2, S2, E2);
                    }
                }
            } else {
                const int last = (l == DEPTH - 1);
                RowPass R{A->x, A->ctx, A->out, xc, Yb, Hb, modp, A->g_post_ffn + l * DM, A->g_pre_mix + (last ? l : l + 1) * DM, 0, 1, last ? 0 : 1, l, 5, last ? l : l + 1, 0, last};
                row_pass(R, gw, ngw, lane);
            }
        }
        if (st + 1 < A_.ph_hi * 2) { if (A_.ph_hi < 0) grid.sync(); else { XcdBarrier bar; bar.bar = (unsigned*)(A->ws + WS_BAR); bar.x = xb_xcc_id(); bar.st = (volatile LAS unsigned*)((LAS unsigned char*)lds + LDS_STAGE); xcd_barrier(bar); } }
    }
}

#ifndef N_LAUNCH_MODE
#define N_LAUNCH_MODE 1
#endif
extern "C" void kernel_launch(void* const* d_in, const int* in_sizes, int n_in, void* d_out, int out_size, void* d_ws, size_t ws_size, hipStream_t stream) {
    static int grid = 0;
    if (grid == 0) {
        if (n_in != 20 || ws_size < WS_TOTAL) { fprintf(stderr, "kernel_launch: n_in %d ws %zu (need %zu)\n", n_in, ws_size, (size_t)WS_TOTAL); grid = -1; return; }
        int dev = 0, cus = 0, per_cu = 0;
        hipGetDevice(&dev); hipDeviceGetAttribute(&cus, hipDeviceAttributeMultiprocessorCount, dev);
        if (hipFuncSetAttribute((const void*)fwd_kernel, hipFuncAttributeMaxDynamicSharedMemorySize, LDS_BYTES) != hipSuccess) { fprintf(stderr, "kernel_launch: hipFuncSetAttribute failed\n"); grid = -1; return; }
        if (hipOccupancyMaxActiveBlocksPerMultiprocessor(&per_cu, (const void*)fwd_kernel, NTHR, LDS_BYTES) != hipSuccess || per_cu < 1) { fprintf(stderr, "kernel_launch: occupancy query gave %d\n", per_cu); per_cu = 1; }
        (void)hipGetLastError();
        grid = cus;
    }
    if (grid < 0) return;
    if (hipMemsetAsync((char*)d_ws + WS_BAR, 0, BAR_BYTES, stream) != hipSuccess) { fprintf(stderr, "kernel_launch: memset failed\n"); return; }
    Args a{};
    const float** ap = (const float**)&a;
    for (int i = 0; i < 20; ++i) ap[i] = (const float*)d_in[i];
    a.out = (float*)d_out; a.ws = (unsigned char*)d_ws;
#if N_LAUNCH_MODE == 1
    a.ph_lo = 0; a.ph_hi = N_PHASES;
    void* args[] = {&a};
    hipError_t e = hipLaunchCooperativeKernel((const void*)fwd_kernel, dim3(grid), dim3(NTHR), args, LDS_BYTES, stream);
    if (e != hipSuccess) fprintf(stderr, "cooperative launch failed: %s (grid %d)\n", hipGetErrorString(e), grid);
#else
    for (int p = 0; p < N_PHASES; ++p) { a.ph_lo = p; a.ph_hi = p + 1; hipLaunchKernelGGL(fwd_kernel, dim3(grid), dim3(NTHR), LDS_BYTES, stream, a); }
#endif
}
```
